# Optimizing an MI355X kernel written in HIP

```python
import math
import jax, jax.numpy as jnp
from jax import lax
import numpy as np

D_MODEL = 1024
BATCH = 8
SEQ = 2048
DEPTH = 2
DEC_BATCH = 16
DEC_SEQ = 2048
PAST_LEN = 128

CHUNK = 128
A_GROUPS = 8
A_WIDTH = D_MODEL
A_GROUP_DIM = A_WIDTH // A_GROUPS
B_HEADS = 8
B_HEAD_DIM = D_MODEL // (2 * B_HEADS)
B_WIDTH = B_HEADS * 2 * B_HEAD_DIM
Q_BLOCK = 128
ATTN_SCALE = B_HEAD_DIM ** -0.5
N_BUCKETS = 32
MAX_DIST = 128
D_FF = 2816
CONV_W = 3
EPS = 1e-6
SPLITS = (A_WIDTH, 2 * A_WIDTH, 2 * A_WIDTH + B_WIDTH, 2 * A_WIDTH + 2 * B_WIDTH,
          2 * A_WIDTH + 3 * B_WIDTH, 2 * A_WIDTH + 3 * B_WIDTH + D_MODEL)
IN_COLS = 2 * A_WIDTH + 3 * B_WIDTH + 2 * D_MODEL

kernel_name = "hybrid_sgu_diffattn_encoder"


def rmsnorm(x, g):
    xf = x.astype(jnp.float32)
    y = xf * lax.rsqrt(jnp.mean(xf * xf, axis=-1, keepdims=True) + EPS) * g.astype(jnp.float32)
    return y.astype(x.dtype)


def rel_bucket(rel):
    nb = N_BUCKETS // 2
    max_exact = nb // 2
    ret = jnp.where(rel > 0, nb, 0)
    n = jnp.abs(rel)
    nf = jnp.maximum(n, 1).astype(jnp.float32)
    large = max_exact + (jnp.log(nf / max_exact) / math.log(MAX_DIST / max_exact)
                         * (nb - max_exact)).astype(jnp.int32)
    large = jnp.minimum(large, nb - 1)
    return ret + jnp.where(n < max_exact, n, large)


def spatial_gating(u, v, g_norm, w_s, b_s):
    bsz, s, _ = v.shape
    v = rmsnorm(v, g_norm)
    vc = v.reshape(bsz, s // CHUNK, CHUNK, A_GROUPS, A_GROUP_DIM)
    mixed = jnp.einsum('gts,bnsgc->bntgc', w_s, vc) + b_s.T[None, None, :, :, None]
    return u * mixed.reshape(bsz, s, A_WIDTH)


def diff_attention(q, k, v, lam, lam_init, bias_table, sub_g):
    bsz, s, _ = q.shape
    q = q.reshape(bsz, s, B_HEADS, 2, B_HEAD_DIM) * ATTN_SCALE
    k = k.reshape(bsz, s, B_HEADS, 2, B_HEAD_DIM)
    v = v.reshape(bsz, s, B_HEADS, 2 * B_HEAD_DIM)
    nblk = s // Q_BLOCK
    qb = q.reshape(bsz, nblk, Q_BLOCK, B_HEADS, 2, B_HEAD_DIM).transpose(1, 0, 2, 3, 4, 5)
    kpos = jnp.arange(s, dtype=jnp.int32)

    def block(args):
        qblk, i = args
        qpos = i * Q_BLOCK + jnp.arange(Q_BLOCK, dtype=jnp.int32)
        bias = bias_table[rel_bucket(kpos[None, :] - qpos[:, None])]
        bias = bias.transpose(2, 0, 1).astype(jnp.float32)
        logits = jnp.einsum('bqhmd,bkhmd->bmhqk', qblk, k).astype(jnp.float32) + bias[None, None]
        p = jax.nn.softmax(logits, axis=-1)
        attn = p[:, 0] - lam * p[:, 1]
        return jnp.einsum('bhqk,bkhd->bqhd', attn.astype(v.dtype), v)

    out = lax.map(block, (qb, jnp.arange(nblk, dtype=jnp.int32)))
    out = out.transpose(1, 0, 2, 3, 4).reshape(bsz, s, B_HEADS, 2 * B_HEAD_DIM)
    out = rmsnorm(out, sub_g) * (1.0 - lam_init)
    return out.reshape(bsz, s, B_WIDTH)


def conv_gated_mlp(h, w_up, conv_w, conv_b, w_down):
    s = h.shape[1]
    up = h @ w_up
    half = CONV_W // 2
    pad = jnp.pad(up, ((0, 0), (half, half), (0, 0)))
    conv = sum(pad[:, j:j + s] * conv_w[j] for j in range(CONV_W)) + conv_b
    a, b = jnp.split(conv, 2, axis=-1)
    return (jax.nn.gelu(a) * b) @ w_down


def trunk(x, rel_bias, g_mix, w_in, sgu_g, sgu_w, sgu_b, lam_qk, sub_g, w_br, w_out,
          g_ffn, w_up, conv_w, conv_b, w_down, g_final):
    for l in range(DEPTH):
        lam_init = 0.8 - 0.6 * math.exp(-0.3 * l)
        lq = lam_qk[l].astype(jnp.float32)
        lam = jnp.exp(jnp.sum(lq[0] * lq[1])) - jnp.exp(jnp.sum(lq[2] * lq[3])) + lam_init
        h = rmsnorm(x, g_mix[l])
        proj = h @ w_in[l]
        u_a, v_a, q, k, v_b, g_a, g_b = jnp.split(proj, SPLITS, axis=-1)
        y_a = spatial_gating(u_a, v_a, sgu_g[l], sgu_w[l], sgu_b[l])
        y_b = diff_attention(q, k, v_b, lam, lam_init, rel_bias, sub_g[l])
        br = jnp.einsum('nbsc,ncd->nbsd', jnp.stack([y_a, y_b], axis=0), w_br[l])
        merged = jax.nn.sigmoid(g_a) * br[0] + jax.nn.sigmoid(g_b) * br[1]
        x = x + merged @ w_out[l]
        x = x + conv_gated_mlp(rmsnorm(x, g_ffn[l]), w_up[l], conv_w[l], conv_b[l], w_down[l])
    return rmsnorm(x, g_final)


def setup_inputs(seed: int = 0) -> dict:
    key = jax.random.key(seed)
    ks = jax.random.split(key, 20)
    f32 = jnp.float32
    nrm = lambda k, shape, scale: jax.random.normal(k, shape, f32) * scale
    return {
        "x_prompt": nrm(ks[0], (BATCH, SEQ, D_MODEL), 1.0),
        "x_sample": nrm(ks[1], (DEC_BATCH, DEC_SEQ, D_MODEL), 1.0),
        "rel_bias": nrm(ks[2], (N_BUCKETS, B_HEADS), 0.5),
        "g_mix": 1.0 + nrm(ks[3], (DEPTH, D_MODEL), 0.02),
        "w_in": nrm(ks[4], (DEPTH, D_MODEL, IN_COLS), D_MODEL ** -0.5),
        "sgu_g": 1.0 + nrm(ks[5], (DEPTH, A_WIDTH), 0.02),
        "sgu_w": nrm(ks[6], (DEPTH, A_GROUPS, CHUNK, CHUNK), 0.5 * CHUNK ** -0.5),
        "sgu_b": 1.0 + nrm(ks[7], (DEPTH, A_GROUPS, CHUNK), 0.1),
        "lam_qk": nrm(ks[8], (DEPTH, 4, B_HEAD_DIM), 0.1),
        "sub_g": 1.0 + nrm(ks[9], (DEPTH, 2 * B_HEAD_DIM), 0.02),
        "w_br": nrm(ks[10], (DEPTH, 2, A_WIDTH, D_MODEL), A_WIDTH ** -0.5),
        "w_out": nrm(ks[11], (DEPTH, D_MODEL, D_MODEL), D_MODEL ** -0.5),
        "g_ffn": 1.0 + nrm(ks[12], (DEPTH, D_MODEL), 0.02),
        "w_up": nrm(ks[13], (DEPTH, D_MODEL, 2 * D_FF), D_MODEL ** -0.5),
        "conv_w": nrm(ks[14], (DEPTH, CONV_W, 2 * D_FF), CONV_W ** -0.5),
        "conv_b": nrm(ks[15], (DEPTH, 2 * D_FF), 0.02),
        "w_down": nrm(ks[16], (DEPTH, D_FF, D_MODEL), D_FF ** -0.5),
        "g_final": 1.0 + nrm(ks[17], (D_MODEL,), 0.02),
    }


def reference(x_prompt, x_sample, rel_bias, g_mix, w_in, sgu_g, sgu_w, sgu_b, lam_qk, sub_g,
              w_br, w_out, g_ffn, w_up, conv_w, conv_b, w_down, g_final):
    y_prompt = trunk(x_prompt, rel_bias, g_mix, w_in, sgu_g, sgu_w, sgu_b, lam_qk, sub_g, w_br,
                     w_out, g_ffn, w_up, conv_w, conv_b, w_down, g_final)
    y_sample = trunk(x_sample, rel_bias, g_mix, w_in, sgu_g, sgu_w, sgu_b, lam_qk, sub_g, w_br,
                     w_out, g_ffn, w_up, conv_w, conv_b, w_down, g_final)
    return (y_prompt, y_sample)
```

```cpp
#include <hip/hip_runtime.h>
#include <hip/hip_cooperative_groups.h>
#include <cstdio>
#include <cstdint>
namespace cg = cooperative_groups;

#ifndef EN_MASK
#define EN_MASK 0x1ff
#endif
#define EN(k) constexpr ((EN_MASK >> (k)) & 1)
#ifndef MK_SINGLE
#define MK_SINGLE 1
#endif

__device__ __forceinline__ int opaque_tid() { int t = threadIdx.x; asm volatile("" : "+v"(t)); return t; }
namespace pg8 {
#define PG8_LAS __attribute__((address_space(3)))
typedef unsigned short bf16_t;
typedef short bf16x8 __attribute__((ext_vector_type(8)));
typedef float f32x4 __attribute__((ext_vector_type(4)));
typedef unsigned u32x4 __attribute__((ext_vector_type(4)));
constexpr int BM = 256, BK = 64, HALF = 128, HTB = HALF * BK * 2  , STAGE_BYTES = 8 * HTB, NXCD = 8, WGM = 8;

__host__ __device__ __forceinline__ int lds_byte(int r, int c) { const int st = (r >> 4) * 2 + (c >> 5), rr = r & 15, cc = c & 31, ob = rr * 64 + cc * 2; return st * 1024 + (ob ^ (((ob >> 9) & 1) << 5)); }
__host__ __device__ __forceinline__ void stage_rc(int b, int& R, int& C) { const int st = b / 1024, sb = b % 1024, swz = sb ^ (((sb >> 9) & 1) << 5); R = (st >> 1) * 16 + swz / 64; C = (st & 1) * 32 + (swz % 64) / 2; }
__host__ __device__ __forceinline__ int perm32(int rho) { const int n = rho >> 4, i = rho & 15; return 8 * (i >> 2) + 4 * n + (i & 3); }

struct Unit { int pm, pn; };
struct Gemm { const bf16_t* A; const bf16_t* Bt; int lda, N, K, M; };

struct StaticOrder {
    int nM, nN, nwg, G, c;
    __host__ __device__ void init(int M, int N, int G_, int c_) { nM = M / BM; nN = N / BM; nwg = nM * nN; G = G_; c = c_; }
    __host__ __device__ bool next(int i, Unit& u) const {
        const long L = (long)i * G + c; if (L >= nwg) return false;
        int wgid = (int)L; { const int q = nwg / NXCD, r = nwg % NXCD, xcd = wgid % NXCD, off = wgid / NXCD; wgid = (xcd < r ? xcd * (q + 1) : r * (q + 1) + (xcd - r) * q) + off; }
        const int nig = WGM * nN, gid = wgid / nig, fm = gid * WGM, gsz = (nM - fm) < WGM ? (nM - fm) : WGM;
        u.pm = fm + ((wgid % nig) % gsz); u.pn = (wgid % nig) / gsz; return true;
    }
    __device__ __forceinline__ void a_ready(const Unit&) const {}
    __device__ __forceinline__ void done(const Unit&) const {}
};

__device__ __forceinline__ unsigned cvt_pk_bf16(float lo, float hi) { unsigned r; asm volatile("v_cvt_pk_bf16_f32 %0, %1, %2" : "=v"(r) : "v"(lo), "v"(hi)); return r; }
__device__ __forceinline__ float bflo(unsigned w) { return __uint_as_float(w << 16); }
__device__ __forceinline__ float bfhi(unsigned w) { return __uint_as_float(w & 0xffff0000u); }
__device__ __forceinline__ u32x4 pack8(const f32x4 a, const f32x4 b) { u32x4 w; w.x = cvt_pk_bf16(a[0], a[1]); w.y = cvt_pk_bf16(a[2], a[3]); w.z = cvt_pk_bf16(b[0], b[1]); w.w = cvt_pk_bf16(b[2], b[3]); return w; }
__device__ __forceinline__ float sigm(float x) { return __builtin_amdgcn_rcpf(1.0f + __builtin_amdgcn_exp2f(-1.4426950408889634f * x)); }
constexpr float RMS_EPS = 1e-6f;
__device__ __forceinline__ float rstd_from16(const float* p) {
    const f32x4 a = *(const f32x4*)p, b = *(const f32x4*)(p + 4), c = *(const f32x4*)(p + 8), d = *(const f32x4*)(p + 12);
    const float s = ((a[0] + a[1]) + (a[2] + a[3])) + ((b[0] + b[1]) + (b[2] + b[3])) + ((c[0] + c[1]) + (c[2] + c[3])) + ((d[0] + d[1]) + (d[2] + d[3]));
    return rsqrtf(s * (1.0f / 1024.0f) + RMS_EPS);
}

template <int MODE> struct EpiRow {
    static constexpr bool PERM = true, AFTER_DRAIN = false;
    bf16_t* O; int ldc; const float* xsq; float* vsq; float qscale;
    __device__ __forceinline__ void operator()(const f32x4 (&acc)[2][2][4][2], const Unit& u, int wr, int wc, int fr, int fq) const {
        const int row0 = u.pm * BM + wr * 64 + fr, col0 = u.pn * BM + wc * 32 + 8 * fq;
        const int sec = u.pn >> 2;
        const float sc = (MODE == 0 && sec == 2) ? qscale : 1.0f;
#pragma unroll
        for (int ai = 0; ai < 2; ++ai)
#pragma unroll
            for (int m = 0; m < 4; ++m) {
                const int row = row0 + ai * HALF + m * 16;
                const float rs = rstd_from16(xsq + (size_t)row * 16) * sc;
                bf16_t* rowp = O + (size_t)row * ldc + col0;
                float vs = 0.f;
#pragma unroll
                for (int bj = 0; bj < 2; ++bj) {
                    const f32x4 v0 = acc[ai][bj][m][0] * rs, v1 = acc[ai][bj][m][1] * rs;
                    if (MODE == 0) vs += (v0[0] * v0[0] + v0[1] * v0[1]) + (v0[2] * v0[2] + v0[3] * v0[3]) + (v1[0] * v1[0] + v1[1] * v1[1]) + (v1[2] * v1[2] + v1[3] * v1[3]);
                    *(u32x4*)(rowp + bj * HALF) = pack8(v0, v1);
                }
                if (MODE == 0 && sec == 1) {
                    vs += __shfl_xor(vs, 16); vs += __shfl_xor(vs, 32);
                    if (fq == 0) vsq[(size_t)row * 16 + (u.pn - 4) * 4 + wc] = vs;
                }
            }
    }
};
template <int STEP> struct EpiGate {
    static constexpr bool PERM = true, AFTER_DRAIN = false;
    bf16_t* O; const bf16_t* G; int ldg;
    __device__ __forceinline__ void operator()(const f32x4 (&acc)[2][2][4][2], const Unit& u, int wr, int wc, int fr, int fq) const {
        const int row0 = u.pm * BM + wr * 64 + fr, col0 = u.pn * BM + wc * 32 + 8 * fq;
#pragma unroll
        for (int ai = 0; ai < 2; ++ai)
#pragma unroll
            for (int m = 0; m < 4; ++m) {
                const int row = row0 + ai * HALF + m * 16;
#pragma unroll
                for (int bj = 0; bj < 2; ++bj) {
                    const u32x4 gv = *(const u32x4*)(G + (size_t)row * ldg + col0 + bj * HALF);
                    bf16_t* op = O + (size_t)row * 1024 + col0 + bj * HALF;
                    f32x4 v0 = acc[ai][bj][m][0], v1 = acc[ai][bj][m][1];
                    v0[0] *= sigm(bflo(gv.x)); v0[1] *= sigm(bfhi(gv.x)); v0[2] *= sigm(bflo(gv.y)); v0[3] *= sigm(bfhi(gv.y));
                    v1[0] *= sigm(bflo(gv.z)); v1[1] *= sigm(bfhi(gv.z)); v1[2] *= sigm(bflo(gv.w)); v1[3] *= sigm(bfhi(gv.w));
                    if (STEP == 1) { const u32x4 ov = *(const u32x4*)op;
                        v0[0] += bflo(ov.x); v0[1] += bfhi(ov.x); v0[2] += bflo(ov.y); v0[3] += bfhi(ov.y);
                        v1[0] += bflo(ov.z); v1[1] += bfhi(ov.z); v1[2] += bflo(ov.w); v1[3] += bfhi(ov.w); }
                    *(u32x4*)op = pack8(v0, v1);
                }
            }
    }
};
struct EpiResid {
    static constexpr bool PERM = true, AFTER_DRAIN = false;
    const float* xin; float* xout; bf16_t* xb; float* sq;
    __device__ __forceinline__ void operator()(const f32x4 (&acc)[2][2][4][2], const Unit& u, int wr, int wc, int fr, int fq) const {
        const int row0 = u.pm * BM + wr * 64 + fr, col0 = u.pn * BM + wc * 32 + 8 * fq;
#pragma unroll
        for (int ai = 0; ai < 2; ++ai)
#pragma unroll
            for (int m = 0; m < 4; ++m) {
                const int row = row0 + ai * HALF + m * 16;
                float s = 0.f;
#pragma unroll
                for (int bj = 0; bj < 2; ++bj) {
                    const size_t off = (size_t)row * 1024 + col0 + bj * HALF;
                    const f32x4 a0 = *(const f32x4*)(xin + off), a1 = *(const f32x4*)(xin + off + 4);
                    const f32x4 v0 = acc[ai][bj][m][0] + a0, v1 = acc[ai][bj][m][1] + a1;
                    s += (v0[0] * v0[0] + v0[1] * v0[1]) + (v0[2] * v0[2] + v0[3] * v0[3]) + (v1[0] * v1[0] + v1[1] * v1[1]) + (v1[2] * v1[2] + v1[3] * v1[3]);
                    *(f32x4*)(xout + off) = v0; *(f32x4*)(xout + off + 4) = v1;
                    *(u32x4*)(xb + off) = pack8(v0, v1);
                }
                s += __shfl_xor(s, 16); s += __shfl_xor(s, 32);
                if (fq == 0) sq[(size_t)row * 16 + u.pn * 4 + wc] = s;
            }
    }
};

template <class Epi, class Sched, bool ALIGN_EPI = false, bool SP2 = false>
__device__ __forceinline__ void gemm_phase(PG8_LAS unsigned char* lds, const Gemm g, const Sched& S, const Epi& E) {
    const int tid = opaque_tid(), wid = __builtin_amdgcn_readfirstlane(tid >> 6), lane = tid & 63, wr = wid >> 2, wc = wid & 3, fr = lane & 15, fq = lane >> 4;
    const int K = g.K, nt = K / BK;
    unsigned voffA[2], voffB[2];
#pragma unroll
    for (int i = 0; i < 2; ++i) { int R, C; stage_rc(tid * 16 + i * 8192, R, C); const int Rb = Epi::PERM ? ((R & ~31) + perm32(R & 31)) : R;
        voffA[i] = (unsigned)(R * g.lda + C) * 2u; voffB[i] = (unsigned)(Rb * K + C) * 2u; }
    const size_t kstep = (size_t)(BK * 2);
    const size_t hstepA = (size_t)HALF * g.lda * 2, hstepB = (size_t)HALF * K * 2;
    const size_t tstepA = 2 * hstepA, tstepB = 2 * hstepB;
    const unsigned ldsw = (unsigned)wid * 1024u;
    const int aoff = lds_byte(wr * 64 + fr, fq * 8), boff = lds_byte(wc * 32 + fr, fq * 8);
#define PG8_SA(b, h) (((b) * 2 + (h)) * HTB)
#define PG8_SB(b, h) ((4 + (b) * 2 + (h)) * HTB)
#define PG8_STAGE(bufoff, gbase, voff) do { _Pragma("unroll") for (int _i = 0; _i < 2; ++_i) \
        __builtin_amdgcn_global_load_lds((const unsigned*)((const char*)(gbase) + (voff)[_i]), (PG8_LAS unsigned*)(lds + (bufoff) + ldsw + _i * 8192), 16, 0, 0); } while (0)
#define PG8_LDA(dst, b, h) do { _Pragma("unroll") for (int m = 0; m < 4; ++m) _Pragma("unroll") for (int k = 0; k < 2; ++k) dst[m][k] = *(const PG8_LAS bf16x8*)(lds + PG8_SA(b, h) + aoff + m * 2048 + k * 1024); } while (0)
#define PG8_LDB(dst, b, h) do { _Pragma("unroll") for (int n = 0; n < 2; ++n) _Pragma("unroll") for (int k = 0; k < 2; ++k) dst[n][k] = *(const PG8_LAS bf16x8*)(lds + PG8_SB(b, h) + boff + n * 2048 + k * 1024); } while (0)
#define PG8_MMA(ai, bj, At, Bt) do { __builtin_amdgcn_s_setprio(1); _Pragma("unroll") for (int m = 0; m < 4; ++m) _Pragma("unroll") for (int n = 0; n < 2; ++n) _Pragma("unroll") for (int k = 0; k < 2; ++k) \
        acc[ai][bj][m][n] = __builtin_amdgcn_mfma_f32_16x16x32_bf16(Bt[n][k], At[m][k], acc[ai][bj][m][n], 0, 0, 0); __builtin_amdgcn_s_setprio(0); } while (0)
#define PG8_WAIT_V(n) asm volatile("s_waitcnt vmcnt(" #n ")" ::: "memory")
#define PG8_WAIT_L(n) asm volatile("s_waitcnt lgkmcnt(" #n ")" ::: "memory")
#define PG8_BAR __builtin_amdgcn_s_barrier()
#define PG8_SCHED __builtin_amdgcn_sched_barrier(0)
    Unit cur, nxt; int ui = 0;
    if (!S.next(0, cur)) return;
    f32x4 acc[2][2][4][2];
#pragma unroll
    for (int a = 0; a < 2; ++a)
#pragma unroll
        for (int b = 0; b < 2; ++b)
#pragma unroll
            for (int m = 0; m < 4; ++m)
#pragma unroll
                for (int n = 0; n < 2; ++n) acc[a][b][m][n] = (f32x4){0.f, 0.f, 0.f, 0.f};
    bf16x8 At[4][2], B0[2][2], B1[2][2];
    const char* cA = (const char*)g.A + (size_t)cur.pm * tstepA; const char* cB = (const char*)g.Bt + (size_t)cur.pn * tstepB;
    S.a_ready(cur);
    if constexpr (SP2) {
        PG8_STAGE(PG8_SB(0, 0), cB, voffB); PG8_STAGE(PG8_SB(0, 1), cB + hstepB, voffB); PG8_STAGE(PG8_SA(0, 0), cA, voffA); PG8_STAGE(PG8_SA(0, 1), cA + hstepA, voffA);
        if (wr == 1) PG8_BAR;
        PG8_WAIT_V(2); PG8_BAR;
        PG8_STAGE(PG8_SB(1, 0), cB + kstep, voffB); PG8_STAGE(PG8_SA(1, 0), cA + kstep, voffA); PG8_STAGE(PG8_SB(1, 1), cB + hstepB + kstep, voffB);
        PG8_WAIT_V(6); PG8_BAR;
    } else {
        PG8_STAGE(PG8_SB(0, 0), cB, voffB); PG8_STAGE(PG8_SA(0, 0), cA, voffA); PG8_STAGE(PG8_SB(0, 1), cB + hstepB, voffB); PG8_STAGE(PG8_SA(0, 1), cA + hstepA, voffA);
        if (wr == 1) PG8_BAR;
        PG8_WAIT_V(4); PG8_BAR;
        PG8_STAGE(PG8_SB(1, 0), cB + kstep, voffB); PG8_STAGE(PG8_SA(1, 0), cA + kstep, voffA); PG8_STAGE(PG8_SB(1, 1), cB + hstepB + kstep, voffB);
        PG8_WAIT_V(6); PG8_BAR;
    }
    for (;;) {
        const bool has_next = S.next(ui + 1, nxt);
        const char* nA = has_next ? (const char*)g.A + (size_t)nxt.pm * tstepA : cA; const char* nB = has_next ? (const char*)g.Bt + (size_t)nxt.pn * tstepB : cB;
        for (int t = 0; t < nt; t += 2) {
            const bool last = (t == nt - 2);
            const char* a1 = cA + (size_t)(t + 1) * kstep;
            const char* a2 = last ? nA : cA + (size_t)(t + 2) * kstep; const char* b2 = last ? nB : cB + (size_t)(t + 2) * kstep;
            const char* a3 = a2 + kstep; const char* b3 = b2 + kstep;
            if (last && has_next) S.a_ready(nxt);
            if constexpr (SP2) {
            PG8_LDB(B0, 0, 0); PG8_LDB(B1, 0, 1); PG8_SCHED; PG8_LDA(At, 0, 0); PG8_STAGE(PG8_SA(1, 1), a1 + hstepA, voffA);
            PG8_WAIT_V(8); PG8_WAIT_L(0); PG8_BAR; PG8_MMA(0, 0, At, B0); PG8_MMA(0, 1, At, B1); PG8_BAR; PG8_SCHED;
            PG8_LDA(At, 0, 1); PG8_STAGE(PG8_SB(0, 0), b2, voffB); PG8_STAGE(PG8_SB(0, 1), b2 + hstepB, voffB); PG8_STAGE(PG8_SA(0, 0), a2, voffA);
            PG8_WAIT_V(8); PG8_WAIT_L(0); PG8_BAR; PG8_MMA(1, 0, At, B0); PG8_MMA(1, 1, At, B1); PG8_BAR; PG8_SCHED;
            PG8_LDB(B0, 1, 0); PG8_LDB(B1, 1, 1); PG8_SCHED; PG8_LDA(At, 1, 0); PG8_STAGE(PG8_SA(0, 1), a2 + hstepA, voffA);
            PG8_WAIT_V(8); PG8_WAIT_L(0); PG8_BAR; PG8_MMA(0, 0, At, B0); PG8_MMA(0, 1, At, B1); PG8_BAR; PG8_SCHED;
            PG8_LDA(At, 1, 1); PG8_STAGE(PG8_SB(1, 0), b3, voffB); PG8_STAGE(PG8_SB(1, 1), b3 + hstepB, voffB); PG8_STAGE(PG8_SA(1, 0), a3, voffA);
            PG8_WAIT_V(8); PG8_WAIT_L(0); PG8_BAR; PG8_MMA(1, 0, At, B0); PG8_MMA(1, 1, At, B1); PG8_BAR; PG8_SCHED;
            } else {
            PG8_LDB(B0, 0, 0); PG8_SCHED; PG8_LDA(At, 0, 0); PG8_STAGE(PG8_SA(1, 1), a1 + hstepA, voffA);
            PG8_WAIT_L(8); PG8_BAR; PG8_WAIT_L(0); PG8_MMA(0, 0, At, B0); PG8_BAR; PG8_SCHED;
            PG8_LDB(B1, 0, 1); PG8_STAGE(PG8_SB(0, 0), b2, voffB);
            PG8_BAR; PG8_WAIT_L(0); PG8_MMA(0, 1, At, B1); PG8_BAR;
            PG8_LDA(At, 0, 1); PG8_STAGE(PG8_SA(0, 0), a2, voffA);
            PG8_BAR; PG8_WAIT_L(0); PG8_MMA(1, 0, At, B0); PG8_BAR; PG8_SCHED;
            PG8_STAGE(PG8_SB(0, 1), b2 + hstepB, voffB);
            PG8_WAIT_V(6); PG8_BAR; PG8_MMA(1, 1, At, B1); PG8_BAR;
            PG8_LDB(B0, 1, 0); PG8_SCHED; PG8_LDA(At, 1, 0); PG8_STAGE(PG8_SA(0, 1), a2 + hstepA, voffA);
            PG8_WAIT_L(8); PG8_BAR; PG8_WAIT_L(0); PG8_MMA(0, 0, At, B0); PG8_BAR; PG8_SCHED;
            PG8_LDB(B1, 1, 1); PG8_STAGE(PG8_SB(1, 0), b3, voffB);
            PG8_BAR; PG8_WAIT_L(0); PG8_MMA(0, 1, At, B1); PG8_BAR;
            PG8_LDA(At, 1, 1); PG8_STAGE(PG8_SA(1, 0), a3, voffA);
            PG8_BAR; PG8_WAIT_L(0); PG8_MMA(1, 0, At, B0); PG8_BAR; PG8_SCHED;
            PG8_STAGE(PG8_SB(1, 1), b3 + hstepB, voffB);
            PG8_WAIT_V(6); PG8_BAR; PG8_MMA(1, 1, At, B1); PG8_BAR;
            }
        }
        if constexpr (ALIGN_EPI) { if (wr == 0) PG8_BAR; }
        if constexpr (!Epi::AFTER_DRAIN) { E(acc, cur, wr, wc, fr, fq); S.done(cur); }
        if (!has_next) break;
#pragma unroll
        for (int a = 0; a < 2; ++a)
#pragma unroll
            for (int b = 0; b < 2; ++b)
#pragma unroll
                for (int m = 0; m < 4; ++m)
#pragma unroll
                    for (int n = 0; n < 2; ++n) acc[a][b][m][n] = (f32x4){0.f, 0.f, 0.f, 0.f};
        cur = nxt; cA = nA; cB = nB; ++ui;
        if constexpr (ALIGN_EPI) { if (wr == 1) PG8_BAR; }
    }
    PG8_WAIT_V(0);
    if constexpr (!ALIGN_EPI) { if (wr == 0) PG8_BAR; }
    PG8_BAR;
    if constexpr (Epi::AFTER_DRAIN) { E.fused(acc, cur, wr, wc, fr, fq, lds, wid, lane); S.done(cur); }
#undef PG8_SA
#undef PG8_SB
#undef PG8_STAGE
#undef PG8_LDA
#undef PG8_LDB
#undef PG8_MMA
#undef PG8_WAIT_V
#undef PG8_WAIT_L
#undef PG8_BAR
#undef PG8_SCHED
}
}

#define LAS __attribute__((address_space(3)))
typedef unsigned short bf16;
typedef float f32x4 __attribute__((ext_vector_type(4)));
typedef float f32x16 __attribute__((ext_vector_type(16)));
typedef short bf16x8 __attribute__((ext_vector_type(8)));
typedef short s16x4 __attribute__((ext_vector_type(4)));
typedef unsigned u32x4 __attribute__((ext_vector_type(4)));
typedef unsigned u32x2 __attribute__((ext_vector_type(2)));

__device__ __forceinline__ float wave_sum(float v) {
#pragma unroll
    for (int o = 1; o < 64; o <<= 1) v += __shfl_xor(v, o);
    return v;
}
__device__ __forceinline__ unsigned f2bf(float f) { unsigned u = __builtin_bit_cast(unsigned, f); return (u + 0x7fffu + ((u >> 16) & 1u)) >> 16; }
__device__ __forceinline__ unsigned pk2(float lo, float hi) { return f2bf(lo) | (f2bf(hi) << 16); }
__device__ __forceinline__ unsigned cvtpk(float lo, float hi) { return pg8::cvt_pk_bf16(lo, hi); }
__device__ __forceinline__ int crow(int r, int hi) { return (r & 3) + 8 * (r >> 2) + 4 * hi; }
__device__ __forceinline__ float ex2(float x) { return __builtin_amdgcn_exp2f(x); }
__device__ __forceinline__ s16x4 trrd(const LAS unsigned char* p) { return __builtin_bit_cast(s16x4, __builtin_amdgcn_ds_read_tr16_b64_v4i16((LAS s16x4*)p)); }
#define XHALF(v, OP) ({ auto rr_ = __builtin_amdgcn_permlane32_swap(__float_as_uint(v), __float_as_uint(v), false, false); OP(__uint_as_float(rr_[0]), __uint_as_float(rr_[1])); })
__device__ __forceinline__ float fmax2(float a, float b) { return __builtin_fmaxf(a, b); }
__device__ __forceinline__ float fadd2(float a, float b) { return a + b; }

constexpr int DM = 1024, SEQ = 2048, DEPTH = 2, INC = 7168, DFF = 2816, DFF2 = 5632;
constexpr int MG = 16384, NGROUP = 3, MT = 49152;
constexpr int C_U = 0, C_VA = 1024, C_Q = 2048, C_K = 3072, C_VB = 4096, C_GA = 5120, C_GB = 6144;
constexpr float LOG2E = 1.4426950408889634f;

namespace att {
constexpr int KP = 272, VP = 320;
constexpr int L_K = 0, L_V = 2 * 64 * KP, L_B = L_V + 2 * 64 * VP, L_Q = L_B + 16384, L_END = L_Q + 8 * 32 * KP;
#define MFMA32(a, b, c) __builtin_amdgcn_mfma_f32_32x32x16_bf16((a), (b), (c), 0, 0, 0)

#define S_TILE(NEAR, mp, s0, s1) do { \
    if (NEAR) { _Pragma("unroll") for (int r = 0; r < 16; ++r) { s0[r] = bp[(r & 3) + 8 * (r >> 2)]; s1[r] = bp[32 + (r & 3) + 8 * (r >> 2)]; } } \
    else { _Pragma("unroll") for (int r = 0; r < 16; ++r) { s0[r] = 0.f; s1[r] = 0.f; } } \
    _Pragma("unroll") for (int d0_ = 0; d0_ < 4; ++d0_) { \
        const bf16x8 k0_ = *(const LAS bf16x8*)(kb + (mp) * 128 + d0_ * 32); \
        const bf16x8 k1_ = *(const LAS bf16x8*)(kb + 32 * KP + (mp) * 128 + d0_ * 32); \
        const bf16x8 q_ = *(const LAS bf16x8*)(qb_ + (mp) * 128 + d0_ * 32); s0 = MFMA32(k0_, q_, s0); s1 = MFMA32(k1_, q_, s1); } } while (0)

#define P1_MAP(NEAR, mp, m, l) do { f32x16 s0, s1; S_TILE(NEAR, mp, s0, s1); \
    float mx = fmax2(s0[0], s1[0]); \
    _Pragma("unroll") for (int r = 1; r < 16; ++r) mx = fmax2(mx, fmax2(s0[r], s1[r])); \
    mx = XHALF(mx, fmax2); \
    const float mn = fmax2(m, mx + coff), sub = mn - coff; float sum = 0.f; \
    _Pragma("unroll") for (int r = 0; r < 16; ++r) sum += ex2(s0[r] - sub) + ex2(s1[r] - sub); \
    l = l * ex2(m - mn) + sum; m = mn; } while (0)

#define S_HALF(NEAR, mp, kh, sv) do { \
    if (NEAR) { _Pragma("unroll") for (int r = 0; r < 16; ++r) sv[r] = bp[32 * (kh) + (r & 3) + 8 * (r >> 2)]; } \
    else { _Pragma("unroll") for (int r = 0; r < 16; ++r) sv[r] = 0.f; } \
    _Pragma("unroll") for (int d0_ = 0; d0_ < 4; ++d0_) { \
        const bf16x8 k0_ = *(const LAS bf16x8*)(kb + (kh) * 32 * KP + (mp) * 128 + d0_ * 32); \
        const bf16x8 q_ = *(const LAS bf16x8*)(qb_ + (mp) * 128 + d0_ * 32); sv = MFMA32(k0_, q_, sv); } } while (0)
#define P2_HALF(NEAR, kh) do { f32x16 ev; bf16x8 pwa, pwb; \
    { f32x16 sv; S_HALF(NEAR, 0, kh, sv); const float sub = m1 - coff; \
      _Pragma("unroll") for (int r = 0; r < 16; ++r) ev[r] = a1 * ex2(sv[r] - sub); } \
    { f32x16 sv; S_HALF(NEAR, 1, kh, sv); const float sub = m2 - coff; \
      _Pragma("unroll") for (int r = 0; r < 16; ++r) ev[r] -= a2 * ex2(sv[r] - sub); } \
    { u32x4 w; \
      w.x = cvtpk(ev[0], ev[1]); w.y = cvtpk(ev[2], ev[3]); w.z = cvtpk(ev[4], ev[5]); w.w = cvtpk(ev[6], ev[7]); pwa = __builtin_bit_cast(bf16x8, w); \
      w.x = cvtpk(ev[8], ev[9]); w.y = cvtpk(ev[10], ev[11]); w.z = cvtpk(ev[12], ev[13]); w.w = cvtpk(ev[14], ev[15]); pwb = __builtin_bit_cast(bf16x8, w); } \
    _Pragma("unroll") for (int db = 0; db < 4; ++db) { \
        { const s16x4 lo = trrd(vb + (32 * (kh)) * VP + db * 64), hh = trrd(vb + (32 * (kh) + 8) * VP + db * 64); \
          const bf16x8 vf = (bf16x8){lo[0], lo[1], lo[2], lo[3], hh[0], hh[1], hh[2], hh[3]}; o[db] = MFMA32(pwa, vf, o[db]); } \
        { const s16x4 lo = trrd(vb + (32 * (kh) + 16) * VP + db * 64), hh = trrd(vb + (32 * (kh) + 24) * VP + db * 64); \
          const bf16x8 vf = (bf16x8){lo[0], lo[1], lo[2], lo[3], hh[0], hh[1], hh[2], hh[3]}; o[db] = MFMA32(pwb, vf, o[db]); } } \
    __builtin_amdgcn_sched_barrier(0); } while (0)

#define TILE_CLASS(t) (((t) * 64 - (qw0 + 31) >= 128) ? 1 : ((qw0 - ((t) * 64 + 63) >= 128) ? -1 : 0))

__device__ __forceinline__ void attn_unit(LAS unsigned char* lds, bf16* proj, int b, int h, int qb, const float* tbh, const float* lq, int layer, const float* subg) {
    const int tid = opaque_tid(), lane = tid & 63, r32 = lane & 31, hi = lane >> 5;
    const int wid = __builtin_amdgcn_readfirstlane(tid >> 6);
    float pa = lq[lane] * lq[64 + lane], pb = lq[128 + lane] * lq[192 + lane];
    pa = wave_sum(pa); pb = wave_sum(pb);
    const float lam = __expf(pa) - __expf(pb) + __uint_as_float(layer ? 0x3EB60549u : 0x3E4CCCCDu);
    LAS float* bl = (LAS float*)(lds + L_B);
#pragma unroll
    for (int i = 0; i < 2; ++i) ((LAS f32x4*)bl)[tid + 512 * i] = ((const f32x4*)tbh)[tid + 512 * i];
    const float cpos = tbh[4095], cneg = tbh[1];
    const size_t rowbase = (size_t)b * SEQ;
    const int qw0 = qb * 256 + wid * 32, qpos = qw0 + r32;
    const LAS float* blq = bl + (2048 - qpos + 4 * hi);
    { const bf16* Qg = proj + (rowbase + qw0 + (lane >> 4)) * INC + C_Q + h * 128 + (lane & 15) * 8;
      LAS unsigned char* qd = lds + L_Q + wid * 32 * KP + (lane >> 4) * KP + (lane & 15) * 16;
#pragma unroll
      for (int i = 0; i < 8; ++i) *(LAS u32x4*)(qd + i * 4 * KP) = *(const u32x4*)(Qg + (size_t)(i * 4) * INC); }
    const LAS unsigned char* qb_ = lds + L_Q + wid * 32 * KP + r32 * KP + hi * 16;
    const int srow = tid >> 4, scc = tid & 15;
    const bf16* kg0 = proj + (rowbase + srow) * INC + C_K + h * 128 + scc * 8;
    const bf16* vg0 = proj + (rowbase + srow) * INC + C_VB + h * 128 + scc * 8;
    LAS unsigned char* kdst = lds + L_K + srow * KP + scc * 16;
    LAS unsigned char* vdst = lds + L_V + srow * VP + scc * 16;
    const LAS unsigned char* kb0 = lds + L_K + r32 * KP + hi * 16;
    u32x4 kr[2], vr[2];
#define LOADK(t) do { _Pragma("unroll") for (int i = 0; i < 2; ++i) kr[i] = *(const u32x4*)(kg0 + (size_t)((t) * 64 + i * 32) * INC); } while (0)
#define LOADV(t) do { _Pragma("unroll") for (int i = 0; i < 2; ++i) vr[i] = *(const u32x4*)(vg0 + (size_t)((t) * 64 + i * 32) * INC); } while (0)
#define STOREK(buf) do { _Pragma("unroll") for (int i = 0; i < 2; ++i) *(LAS u32x4*)(kdst + (buf) * 64 * KP + i * 32 * KP) = kr[i]; } while (0)
#define STOREV(buf) do { _Pragma("unroll") for (int i = 0; i < 2; ++i) *(LAS u32x4*)(vdst + (buf) * 64 * VP + i * 32 * VP) = vr[i]; } while (0)
    float m1 = -1e30f, m2 = -1e30f, l1 = 0.f, l2 = 0.f;
    LOADK(0); STOREK(0);
    __syncthreads();
    for (int t = 0; t < 32; ++t) {
        const int buf = t & 1;
        if (t + 1 < 32) LOADK(t + 1);
        const LAS unsigned char* kb = kb0 + buf * 64 * KP;
        const int tc = TILE_CLASS(t);
        if (tc == 0) { const LAS float* bp = blq + t * 64; const float coff = 0.f; P1_MAP(true, 0, m1, l1); P1_MAP(true, 1, m2, l2); }
        else { const LAS float* bp = blq; const float coff = tc > 0 ? cpos : cneg; P1_MAP(false, 0, m1, l1); P1_MAP(false, 1, m2, l2); }
        if (t + 1 < 32) STOREK(buf ^ 1);
        __syncthreads();
    }
    l1 = XHALF(l1, fadd2); l2 = XHALF(l2, fadd2);
    const float a1 = 1.0f / l1, a2 = lam / l2;
    f32x16 o[4];
#pragma unroll
    for (int i = 0; i < 4; ++i)
#pragma unroll
        for (int r = 0; r < 16; ++r) o[i][r] = 0.f;
    const LAS unsigned char* vb0 = lds + L_V + (4 * hi + ((lane >> 2) & 3)) * VP + (((lane >> 4) & 1) * 16 + (lane & 3) * 4) * 2;
    LOADK(0); LOADV(0); STOREK(0); STOREV(0);
    __syncthreads();
    for (int t = 0; t < 32; ++t) {
        const int buf = t & 1;
        if (t + 1 < 32) { LOADK(t + 1); LOADV(t + 1); }
        const LAS unsigned char* kb = kb0 + buf * 64 * KP;
        const LAS unsigned char* vb = vb0 + buf * 64 * VP;
        const int tc = TILE_CLASS(t);
        if (tc == 0) { const LAS float* bp = blq + t * 64; const float coff = 0.f; P2_HALF(true, 0); P2_HALF(true, 1); }
        else { const LAS float* bp = blq; const float coff = tc > 0 ? cpos : cneg; P2_HALF(false, 0); P2_HALF(false, 1); }
        if (t + 1 < 32) { STOREK(buf ^ 1); STOREV(buf ^ 1); }
        __syncthreads();
    }
    float gsc[4];
    const float oml = __uint_as_float(layer ? 0x3F24FD5Cu : 0x3F4CCCCDu);
#pragma unroll
    for (int db = 0; db < 4; ++db) gsc[db] = subg[db * 32 + r32] * oml;
    bf16* Op = proj + (rowbase + qw0) * INC + C_Q + h * 128 + r32;
#pragma unroll
    for (int r = 0; r < 16; ++r) {
        float ss = (o[0][r] * o[0][r] + o[1][r] * o[1][r]) + (o[2][r] * o[2][r] + o[3][r] * o[3][r]);
#pragma unroll
        for (int of = 1; of < 32; of <<= 1) ss += __shfl_xor(ss, of);
        const float rs = rsqrtf(ss * (1.0f / 128.0f) + 1e-6f);
        bf16* op = Op + (size_t)crow(r, hi) * INC;
#pragma unroll
        for (int db = 0; db < 4; ++db) op[db * 32] = (bf16)f2bf(o[db][r] * rs * gsc[db]);
    }
#undef LOADK
#undef LOADV
#undef STOREK
#undef STOREV
}
}

namespace sgu {
constexpr int VP = 320, L_R = 128 * VP;
__device__ __forceinline__ void sgu_unit(LAS unsigned char* lds, bf16* proj, int n, int g, const float* W, const float* bvec, const float* gch, const float* vsq) {
    const int tid = opaque_tid(), lane = tid & 63, r32 = lane & 31, hi = lane >> 5;
    const int wid = __builtin_amdgcn_readfirstlane(tid >> 6);
    LAS float* rl = (LAS float*)(lds + L_R);
    const size_t row0 = (size_t)n * 128;
#pragma unroll
    for (int i = 0; i < 4; ++i) { const int c = tid + 512 * i, row = c >> 4, cc = c & 15;
        *(LAS u32x4*)(lds + row * VP + cc * 16) = *(const u32x4*)(proj + (row0 + row) * INC + C_VA + g * 128 + cc * 8); }
    if (tid < 128) rl[tid] = pg8::rstd_from16(vsq + (row0 + tid) * 16);
    __syncthreads();
    const int tblk = wid >> 1, cb0 = 2 * (wid & 1);
    f32x16 acc[2];
#pragma unroll
    for (int c = 0; c < 2; ++c)
#pragma unroll
        for (int r = 0; r < 16; ++r) acc[c][r] = 0.f;
    const float* Wr = W + (size_t)(tblk * 32 + r32) * 128 + hi * 4;
    const LAS unsigned char* vb = lds + (4 * hi + ((lane >> 2) & 3)) * VP + (((lane >> 4) & 1) * 16 + (lane & 3) * 4) * 2;
#pragma unroll
    for (int ks = 0; ks < 8; ++ks) {
        const f32x4 w0 = *(const f32x4*)(Wr + ks * 16), w1 = *(const f32x4*)(Wr + ks * 16 + 8);
        const f32x4 r0 = *(const LAS f32x4*)(rl + ks * 16 + hi * 4), r1 = *(const LAS f32x4*)(rl + ks * 16 + hi * 4 + 8);
        const f32x4 a0 = w0 * r0, a1 = w1 * r1;
        const bf16x8 af = __builtin_bit_cast(bf16x8, pg8::pack8(a0, a1));
#pragma unroll
        for (int c = 0; c < 2; ++c) {
            const s16x4 lo = trrd(vb + (16 * ks) * VP + (cb0 + c) * 64), hh = trrd(vb + (16 * ks + 8) * VP + (cb0 + c) * 64);
            const bf16x8 vf = (bf16x8){lo[0], lo[1], lo[2], lo[3], hh[0], hh[1], hh[2], hh[3]};
            acc[c] = MFMA32(af, vf, acc[c]);
        }
    }
#pragma unroll
    for (int c = 0; c < 2; ++c) {
        const int ch = (cb0 + c) * 32 + r32;
        const float gs = gch[ch];
        bf16* up = proj + row0 * INC + C_U + g * 128 + ch;
#pragma unroll
        for (int r = 0; r < 16; ++r) {
            const int t = tblk * 32 + crow(r, hi);
            bf16* p = up + (size_t)t * INC;
            const float u = __uint_as_float((unsigned)(*p) << 16);
            *p = (bf16)f2bf(u * (gs * acc[c][r] + bvec[t]));
        }
    }
    __syncthreads();
}
}

constexpr size_t MiB = 1u << 20;
constexpr size_t WS_TB = 0, WS_VSQ = 1 * MiB, WS_XSQ = 2 * MiB, WS_WIN = 6 * MiB, WS_WBR = 34 * MiB, WS_WOUT = 42 * MiB, WS_WUP = 46 * MiB, WS_WDN = 68 * MiB;
constexpr size_t WS_XB = 80 * MiB, WS_PROJ = 176 * MiB, WS_MRG = 400 * MiB, WS_END = 488 * MiB;
static_assert(WS_WIN + (size_t)DEPTH * INC * DM * 2 <= WS_WBR && WS_WUP + (size_t)DEPTH * DFF2 * DM * 2 <= WS_WDN && WS_WDN + (size_t)DEPTH * DM * DFF * 2 <= WS_XB, "weights map");
static_assert(WS_XB + (size_t)MT * DM * 2 <= WS_PROJ && WS_PROJ + (size_t)MG * INC * 2 <= WS_MRG && WS_MRG + (size_t)MG * DFF * 2 <= WS_END, "activation map");
constexpr int LDS_BYTES = 163840;
static_assert(att::L_END <= LDS_BYTES, "attention LDS map");
constexpr int NWAVES = 8, NTHREADS = 512;
constexpr int NPH = 1 + NGROUP * 15;

__device__ __forceinline__ void transpose_item(const float* W, const float* gk, int K, int N, bf16* WT, LAS float* scr, int item, int lane) {
    const int nblk = N / 32, kb = item / nblk, nb = item % nblk, k0 = 64 * kb, n0 = 32 * nb;
#pragma unroll 8
    for (int i = 0; i < 32; ++i) { const int kk = 2 * i + (lane >> 5); const float sc = gk ? gk[k0 + kk] : 1.0f; scr[kk * 33 + (lane & 31)] = W[(size_t)(k0 + kk) * N + n0 + (lane & 31)] * sc; }
    asm volatile("s_waitcnt lgkmcnt(0)" ::: "memory");
    const int c = lane & 7;
#pragma unroll
    for (int j = 0; j < 4; ++j) { const int n = (lane >> 3) + 8 * j; const LAS float* s = scr + (8 * c) * 33 + n;
        u32x4 o; o.x = pk2(s[0 * 33], s[1 * 33]); o.y = pk2(s[2 * 33], s[3 * 33]); o.z = pk2(s[4 * 33], s[5 * 33]); o.w = pk2(s[6 * 33], s[7 * 33]);
        *(u32x4*)(WT + (size_t)(n0 + n) * K + k0 + 8 * c) = o; }
    asm volatile("s_waitcnt lgkmcnt(0)" ::: "memory");
}
__device__ __forceinline__ int rel_bucket(int rel) {
    const int n = rel < 0 ? -rel : rel;
    const int large = 8 + (n >= 12) + (n >= 16) + (n >= 23) + (n >= 32) + (n >= 46) + (n >= 64) + (n >= 91);
    return (rel > 0 ? 16 : 0) + (n < 8 ? n : large);
}
__device__ __forceinline__ void ld8(const bf16* p, float (&a)[8]) {
    const u32x4 v = *(const u32x4*)p;
    a[0] = pg8::bflo(v.x); a[1] = pg8::bfhi(v.x); a[2] = pg8::bflo(v.y); a[3] = pg8::bfhi(v.y); a[4] = pg8::bflo(v.z); a[5] = pg8::bfhi(v.z); a[6] = pg8::bflo(v.w); a[7] = pg8::bfhi(v.w);
}
__device__ __forceinline__ void ld8f(const float* p, float (&a)[8]) {
    const f32x4 v0 = *(const f32x4*)p, v1 = *(const f32x4*)(p + 4);
    a[0] = v0[0]; a[1] = v0[1]; a[2] = v0[2]; a[3] = v0[3]; a[4] = v1[0]; a[5] = v1[1]; a[6] = v1[2]; a[7] = v1[3];
}
__device__ __forceinline__ float gelu_tanh(float x) {
    const float z = 0.7978845608028654f * (x + 0.044715f * x * x * x);
    return x * __builtin_amdgcn_rcpf(1.0f + __builtin_amdgcn_exp2f(-2.0f * LOG2E * z));
}
__device__ __forceinline__ void conv_gate_phase(const bf16* up, bf16* hg, const float* cw, const float* cbias, int gtid, int gthreads) {
    constexpr int R = 16, NCH = DFF / 8;
    const int nitems = (MG / R) * NCH;
    for (int it = gtid; it < nitems; it += gthreads) {
        const int rb = it / NCH, ch = it - rb * NCH, col = ch * 8, row0 = rb * R, t0 = row0 & (SEQ - 1);
        float wa[3][8], wb[3][8], ba[8], bb[8];
#pragma unroll
        for (int j = 0; j < 3; ++j) { ld8f(cw + (size_t)j * DFF2 + col, wa[j]); ld8f(cw + (size_t)j * DFF2 + DFF + col, wb[j]); }
        ld8f(cbias + col, ba); ld8f(cbias + DFF + col, bb);
        float pa[8], pb[8], ca[8], cb[8], na[8], nb[8];
        const bf16* urow = up + (size_t)row0 * DFF2 + col;
        if (t0 == 0) {
#pragma unroll
            for (int e = 0; e < 8; ++e) { pa[e] = 0.f; pb[e] = 0.f; }
        } else { ld8(urow - DFF2, pa); ld8(urow - DFF2 + DFF, pb); }
        ld8(urow, ca); ld8(urow + DFF, cb);
#pragma unroll 4
        for (int r = 0; r < R; ++r) {
            if (t0 + r + 1 == SEQ) {
#pragma unroll
                for (int e = 0; e < 8; ++e) { na[e] = 0.f; nb[e] = 0.f; }
            } else { ld8(urow + (size_t)(r + 1) * DFF2, na); ld8(urow + (size_t)(r + 1) * DFF2 + DFF, nb); }
            float o[8];
#pragma unroll
            for (int e = 0; e < 8; ++e) {
                const float va = pa[e] * wa[0][e] + ca[e] * wa[1][e] + na[e] * wa[2][e] + ba[e];
                const float vb = pb[e] * wb[0][e] + cb[e] * wb[1][e] + nb[e] * wb[2][e] + bb[e];
                o[e] = gelu_tanh(va) * vb;
            }
            u32x4 w; w.x = cvtpk(o[0], o[1]); w.y = cvtpk(o[2], o[3]); w.z = cvtpk(o[4], o[5]); w.w = cvtpk(o[6], o[7]);
            *(u32x4*)(hg + (size_t)(row0 + r) * DFF + col) = w;
#pragma unroll
            for (int e = 0; e < 8; ++e) { pa[e] = ca[e]; pb[e] = cb[e]; ca[e] = na[e]; cb[e] = nb[e]; }
        }
    }
}

struct Args { const float* in[18]; float* out; unsigned char* ws; int ph_lo, ph_hi; };
static_assert(sizeof(Args) == 168, "Args layout");

__global__ void __launch_bounds__(NTHREADS) mk_fwd(Args a) {
    extern __shared__ __attribute__((aligned(16))) unsigned char lds_raw[];
    LAS unsigned char* lds = (LAS unsigned char*)lds_raw;
    cg::grid_group grid = cg::this_grid();
    const int G = gridDim.x, bx = blockIdx.x;
    const int vcu = __builtin_amdgcn_readfirstlane((G % 8 == 0) ? (bx % 8) * (G / 8) + bx / 8 : bx);
    const __attribute__((address_space(4))) unsigned char* ka = (const __attribute__((address_space(4))) unsigned char*)__builtin_amdgcn_kernarg_segment_ptr();
    const int ph_lo = *(const __attribute__((address_space(4))) int*)(ka + 160), ph_hi = *(const __attribute__((address_space(4))) int*)(ka + 164);
    for (int ph = ph_lo; ph < ph_hi; ++ph) {
        const int tid = opaque_tid(), lane = tid & 63, wave = __builtin_amdgcn_readfirstlane(tid >> 6);
        const __attribute__((address_space(4))) unsigned char* kp = ka; asm volatile("" : "+s"(kp));
#define KARG_F(i) (*(const float* const __attribute__((address_space(4)))*)(kp + 8 * (i)))
        unsigned char* ws = *(unsigned char* const __attribute__((address_space(4)))*)(kp + 152);
        float* const outp = *(float* const __attribute__((address_space(4)))*)(kp + 144);
        float* tb = (float*)(ws + WS_TB); float* vsq = (float*)(ws + WS_VSQ); float* xsq = (float*)(ws + WS_XSQ);
        bf16* Win_t = (bf16*)(ws + WS_WIN); bf16* Wbr_t = (bf16*)(ws + WS_WBR); bf16* Wout_t = (bf16*)(ws + WS_WOUT); bf16* Wup_t = (bf16*)(ws + WS_WUP); bf16* Wdn_t = (bf16*)(ws + WS_WDN);
        bf16* xb = (bf16*)(ws + WS_XB); bf16* proj = (bf16*)(ws + WS_PROJ); bf16* upb = (bf16*)(ws + WS_PROJ); bf16* mrg = (bf16*)(ws + WS_MRG); bf16* hg = (bf16*)(ws + WS_MRG);
#define x_prompt KARG_F(0)
#define x_sample KARG_F(1)
#define rel_bias KARG_F(2)
#define g_mix KARG_F(3)
#define w_in KARG_F(4)
#define sgu_g KARG_F(5)
#define sgu_w KARG_F(6)
#define sgu_b KARG_F(7)
#define lam_qk KARG_F(8)
#define sub_g KARG_F(9)
#define w_br KARG_F(10)
#define w_out KARG_F(11)
#define g_ffn KARG_F(12)
#define w_up KARG_F(13)
#define conv_w KARG_F(14)
#define conv_b KARG_F(15)
#define w_down KARG_F(16)
#define g_final KARG_F(17)

        if (ph == 0) { if EN(7) {
            LAS float* scr = (LAS float*)(lds + wave * 16384);
            const int gw = vcu * NWAVES + wave, NGW = G * NWAVES;
            constexpr int I_IN = (DM / 64) * (INC / 32), I_SQ = (DM / 64) * (DM / 32), I_UP = (DM / 64) * (DFF2 / 32), I_DN = (DFF / 64) * (DM / 32);
            constexpr int I_L = I_IN + 3 * I_SQ + I_UP + I_DN;
            for (int it = gw; it < DEPTH * I_L; it += NGW) {
                const int l = it / I_L; int r = it - l * I_L;
                if (r < I_IN) { transpose_item(w_in + (size_t)l * DM * INC, g_mix + l * DM, DM, INC, Win_t + (size_t)l * INC * DM, scr, r, lane); continue; } r -= I_IN;
                if (r < 2 * I_SQ) { const int j = r / I_SQ; transpose_item(w_br + (size_t)(l * 2 + j) * DM * DM, nullptr, DM, DM, Wbr_t + (size_t)(l * 2 + j) * DM * DM, scr, r - j * I_SQ, lane); continue; } r -= 2 * I_SQ;
                if (r < I_SQ) { transpose_item(w_out + (size_t)l * DM * DM, nullptr, DM, DM, Wout_t + (size_t)l * DM * DM, scr, r, lane); continue; } r -= I_SQ;
                if (r < I_UP) { transpose_item(w_up + (size_t)l * DM * DFF2, g_ffn + l * DM, DM, DFF2, Wup_t + (size_t)l * DFF2 * DM, scr, r, lane); continue; } r -= I_UP;
                transpose_item(w_down + (size_t)l * DFF * DM, nullptr, DFF, DM, Wdn_t + (size_t)l * DM * DFF, scr, r, lane);
            }
            for (int i = bx * NTHREADS + tid; i < 8 * 4096; i += G * NTHREADS) { const int h = i >> 12, rel = (i & 4095) - 2048; tb[i] = rel_bias[rel_bucket(rel) * 8 + h] * LOG2E; }
            for (int m = gw; m < MT; m += NGW) {
                const float* src = (m < MG) ? x_prompt + (size_t)m * DM : x_sample + (size_t)(m - MG) * DM;
                const f32x4* xr = (const f32x4*)src + lane;
                f32x4 v[4]; float s = 0.f;
#pragma unroll
                for (int j = 0; j < 4; ++j) { v[j] = xr[64 * j]; s += (v[j][0] * v[j][0] + v[j][1] * v[j][1]) + (v[j][2] * v[j][2] + v[j][3] * v[j][3]); }
                s = wave_sum(s);
                u32x2* o8 = (u32x2*)(xb + (size_t)m * DM) + lane;
#pragma unroll
                for (int j = 0; j < 4; ++j) { u32x2 w; w.x = cvtpk(v[j][0], v[j][1]); w.y = cvtpk(v[j][2], v[j][3]); o8[64 * j] = w; }
                if (lane < 16) xsq[(size_t)m * 16 + lane] = (lane == 0) ? s : 0.f;
            }
        } } else {
            const int q = ph - 1, g = q / 15, k15 = q % 15;
            const size_t grow0 = (size_t)g * MG;
            const float* xin_g = (g == 0) ? x_prompt : x_sample + (size_t)(g - 1) * MG * DM;
            float* xres = outp + grow0 * DM; bf16* xb_g = xb + grow0 * DM; float* xsq_g = xsq + grow0 * 16;
            if (k15 == 14) { if EN(8) {
                const int gw = vcu * NWAVES + wave, NGW = G * NWAVES;
                for (int m = gw; m < MG; m += NGW) {
                    const float rs = pg8::rstd_from16(xsq_g + (size_t)m * 16);
                    f32x4* xr = (f32x4*)(xres + (size_t)m * DM) + lane; const f32x4* gr = (const f32x4*)g_final + lane;
#pragma unroll
                    for (int j = 0; j < 4; ++j) xr[64 * j] = xr[64 * j] * rs * gr[64 * j];
                }
            } } else {
                const int l = k15 / 7, k = k15 % 7;
                if (k == 0) { if EN(0) {
                    pg8::Gemm gm{xb_g, Win_t + (size_t)l * INC * DM, DM, INC, DM, MG}; pg8::StaticOrder S; S.init(MG, INC, G, bx);
                    pg8::EpiRow<0> E{proj, INC, xsq_g, vsq, 0.125f * LOG2E};
                    pg8::gemm_phase<pg8::EpiRow<0>, pg8::StaticOrder, true, true>(lds, gm, S, E);
                } } else if (k == 1) { if EN(1) {
#ifndef NO_ATT
                    for (int i = 0; i < 2; ++i) { const int id = i * G + vcu; if (id >= 512) break; const int bh = id >> 3, qb = id & 7;
                        att::attn_unit(lds, proj, bh >> 3, bh & 7, qb, tb + (bh & 7) * 4096, lam_qk + l * 256, l, sub_g + l * 128); __syncthreads(); }
#endif
#ifndef NO_SGU
                    for (int i = 0; i < 4; ++i) { const int id = i * G + vcu; if (id >= 1024) break; const int n = id >> 3, gc = id & 7;
                        sgu::sgu_unit(lds, proj, n, gc, sgu_w + ((size_t)l * 8 + gc) * 128 * 128, sgu_b + (l * 8 + gc) * 128, sgu_g + l * DM + gc * 128, vsq); }
#endif
                } } else if (k == 2) { if EN(2) {
                    { pg8::Gemm gm{proj + C_U, Wbr_t + (size_t)(l * 2 + 0) * DM * DM, INC, DM, DM, MG}; pg8::StaticOrder S; S.init(MG, DM, G, bx);
                      pg8::EpiGate<0> E{mrg, proj + C_GA, INC};
                      pg8::gemm_phase<pg8::EpiGate<0>, pg8::StaticOrder, true, true>(lds, gm, S, E); }
                    asm volatile("s_waitcnt vmcnt(0)" ::: "memory"); __syncthreads();
                    { pg8::Gemm gm{proj + C_Q, Wbr_t + (size_t)(l * 2 + 1) * DM * DM, INC, DM, DM, MG}; pg8::StaticOrder S; S.init(MG, DM, G, bx);
                      pg8::EpiGate<1> E{mrg, proj + C_GB, INC};
                      pg8::gemm_phase<pg8::EpiGate<1>, pg8::StaticOrder, true, true>(lds, gm, S, E); }
                } } else if (k == 3) { if EN(3) {
                    pg8::Gemm gm{mrg, Wout_t + (size_t)l * DM * DM, DM, DM, DM, MG}; pg8::StaticOrder S; S.init(MG, DM, G, bx);
                    pg8::EpiResid E{(l == 0) ? xin_g : (const float*)xres, xres, xb_g, xsq_g};
                    pg8::gemm_phase<pg8::EpiResid, pg8::StaticOrder, true, true>(lds, gm, S, E);
                } } else if (k == 4) { if EN(4) {
                    pg8::Gemm gm{xb_g, Wup_t + (size_t)l * DFF2 * DM, DM, DFF2, DM, MG}; pg8::StaticOrder S; S.init(MG, DFF2, G, bx);
                    pg8::EpiRow<1> E{upb, DFF2, xsq_g, nullptr, 1.0f};
                    pg8::gemm_phase<pg8::EpiRow<1>, pg8::StaticOrder, true, true>(lds, gm, S, E);
                } } else if (k == 5) { if EN(5) {
                    conv_gate_phase(upb, hg, conv_w + (size_t)l * 3 * DFF2, conv_b + (size_t)l * DFF2, bx * NTHREADS + tid, G * NTHREADS);
                } } else { if EN(6) {
                    pg8::Gemm gm{hg, Wdn_t + (size_t)l * DM * DFF, DFF, DM, DFF, MG}; pg8::StaticOrder S; S.init(MG, DM, G, bx);
                    pg8::EpiResid E{xres, xres, xb_g, xsq_g};
                    pg8::gemm_phase<pg8::EpiResid, pg8::StaticOrder, true, true>(lds, gm, S, E);
                } }
            }
        }
        if (ph + 1 < ph_hi) grid.sync();
    }
}

extern "C" void kernel_launch(void* const* d_in, const int* in_sizes, int n_in, void* d_out, int out_size, void* d_ws, size_t ws_size, hipStream_t stream) {
    static int grid = 0;
    if (grid == 0) {
        if (n_in != 18 || in_sizes[0] != MG * DM || in_sizes[1] != 2 * MG * DM || out_size != MT * DM || ws_size < WS_END) {
            fprintf(stderr, "kernel_launch: unexpected shapes (n_in %d, ws %zu); nothing launched\n", n_in, ws_size); grid = -1; return; }
        int dev = 0, cus = 0, per_cu = 0;
        hipGetDevice(&dev); hipDeviceGetAttribute(&cus, hipDeviceAttributeMultiprocessorCount, dev);
        if (hipFuncSetAttribute((const void*)mk_fwd, hipFuncAttributeMaxDynamicSharedMemorySize, LDS_BYTES) != hipSuccess) { fprintf(stderr, "kernel_launch: hipFuncSetAttribute failed\n"); grid = -1; return; }
        if (hipOccupancyMaxActiveBlocksPerMultiprocessor(&per_cu, (const void*)mk_fwd, NTHREADS, LDS_BYTES) != hipSuccess || per_cu < 1) { per_cu = 1; (void)hipGetLastError(); }
        grid = cus * 1;
        if (grid <= 0) { grid = -1; return; }
    }
    if (grid < 0) return;
    Args a{};
    for (int i = 0; i < 18; ++i) a.in[i] = (const float*)d_in[i];
    a.out = (float*)d_out; a.ws = (unsigned char*)d_ws;
#if MK_SINGLE
    a.ph_lo = 0; a.ph_hi = NPH;
    void* args[] = {&a};
    hipError_t e = hipLaunchCooperativeKernel((const void*)mk_fwd, dim3(grid), dim3(NTHREADS), args, LDS_BYTES, stream);
    if (e != hipSuccess) fprintf(stderr, "cooperative launch failed: %s (grid %d)\n", hipGetErrorString(e), grid);
#else
    for (int ph = 0; ph < NPH; ++ph) { a.ph_lo = ph; a.ph_hi = ph + 1; hipLaunchKernelGGL(mk_fwd, dim3(grid), dim3(NTHREADS), LDS_BYTES, stream, a); }
#endif
}
```

```cpp
#include <hip/hip_runtime.h>
#include <hip/hip_cooperative_groups.h>
#include <cstdio>
#include <cstdint>
namespace cg = cooperative_groups;

#ifndef EN_MASK
#define EN_MASK 0x1ff
#endif
#define EN(k) constexpr ((EN_MASK >> (k)) & 1)
#ifndef PROBE
#define PROBE 0
#endif
#ifndef MK_SINGLE
#define MK_SINGLE 1
#endif

__device__ __forceinline__ int opaque_tid() { int t = threadIdx.x; asm volatile("" : "+v"(t)); return t; }
namespace pg8 {
#define PG8_LAS __attribute__((address_space(3)))
typedef unsigned short bf16_t;
typedef short bf16x8 __attribute__((ext_vector_type(8)));
typedef float f32x4 __attribute__((ext_vector_type(4)));
typedef unsigned u32x4 __attribute__((ext_vector_type(4)));
constexpr int BM = 256, BK = 64, HALF = 128, HTB = HALF * BK * 2  , STAGE_BYTES = 8 * HTB, NXCD = 8, WGM = 8;

__host__ __device__ __forceinline__ int lds_byte(int r, int c) { const int st = (r >> 4) * 2 + (c >> 5), rr = r & 15, cc = c & 31, ob = rr * 64 + cc * 2; return st * 1024 + (ob ^ (((ob >> 9) & 1) << 5)); }
__host__ __device__ __forceinline__ void stage_rc(int b, int& R, int& C) { const int st = b / 1024, sb = b % 1024, swz = sb ^ (((sb >> 9) & 1) << 5); R = (st >> 1) * 16 + swz / 64; C = (st & 1) * 32 + (swz % 64) / 2; }
__host__ __device__ __forceinline__ int perm32(int rho) { const int n = rho >> 4, i = rho & 15; return 8 * (i >> 2) + 4 * n + (i & 3); }

struct Unit { int pm, pn, w; };
struct Gemm { const bf16_t* A; const bf16_t* Bt; int lda, N, K, M; size_t a2, b2; };

struct StaticOrder {
    int nM, nN, nwg, G, c;
    __host__ __device__ void init(int M, int N, int G_, int c_) { nM = M / BM; nN = N / BM; nwg = nM * nN; G = G_; c = c_; }
    __host__ __device__ bool next(int i, Unit& u) const {
        const long L = (long)i * G + c; if (L >= nwg) return false;
        int wgid = (int)L; { const int q = nwg / NXCD, r = nwg % NXCD, xcd = wgid % NXCD, off = wgid / NXCD; wgid = (xcd < r ? xcd * (q + 1) : r * (q + 1) + (xcd - r) * q) + off; }
        const int nig = WGM * nN, gid = wgid / nig, fm = gid * WGM, gsz = (nM - fm) < WGM ? (nM - fm) : WGM;
        u.pm = fm + ((wgid % nig) % gsz); u.pn = (wgid % nig) / gsz; u.w = 0; return true;
    }
    __device__ __forceinline__ void a_ready(const Unit&) const {}
    __device__ __forceinline__ void done(const Unit&) const {}
};

struct PairOrder {
    StaticOrder base;
    __host__ __device__ void init(int M, int N, int G_, int c_) { base.init(M, N, G_, c_); }
    __host__ __device__ bool next(int i, Unit& u) const { if (!base.next(i >> 1, u)) return false; u.w = i & 1; return true; }
    __device__ __forceinline__ void a_ready(const Unit&) const {}
    __device__ __forceinline__ void done(const Unit&) const {}
};

struct RotOrder {
    StaticOrder base; int first;
    __host__ __device__ void init(int M, int N, int G_, int c_, int first_) { base.init(M, N, G_, c_); first = first_; }
    __host__ __device__ bool next(int i, Unit& u) const { if (!base.next(i, u)) return false; u.pn += first; if (u.pn >= base.nN) u.pn -= base.nN; return true; }
    __device__ __forceinline__ void a_ready(const Unit&) const {}
    __device__ __forceinline__ void done(const Unit&) const {}
};

__device__ __forceinline__ unsigned cvt_pk_bf16(float lo, float hi) { unsigned r; asm volatile("v_cvt_pk_bf16_f32 %0, %1, %2" : "=v"(r) : "v"(lo), "v"(hi)); return r; }
__device__ __forceinline__ float bflo(unsigned w) { return __uint_as_float(w << 16); }
__device__ __forceinline__ float bfhi(unsigned w) { return __uint_as_float(w & 0xffff0000u); }
__device__ __forceinline__ u32x4 pack8(const f32x4 a, const f32x4 b) { u32x4 w; w.x = cvt_pk_bf16(a[0], a[1]); w.y = cvt_pk_bf16(a[2], a[3]); w.z = cvt_pk_bf16(b[0], b[1]); w.w = cvt_pk_bf16(b[2], b[3]); return w; }
__device__ __forceinline__ float sigm(float x) { return __builtin_amdgcn_rcpf(1.0f + __builtin_amdgcn_exp2f(-1.4426950408889634f * x)); }
constexpr float RMS_EPS = 1e-6f;
__device__ __forceinline__ float rstd_from16(const float* p) {
    const f32x4 a = *(const f32x4*)p, b = *(const f32x4*)(p + 4), c = *(const f32x4*)(p + 8), d = *(const f32x4*)(p + 12);
    const float s = ((a[0] + a[1]) + (a[2] + a[3])) + ((b[0] + b[1]) + (b[2] + b[3])) + ((c[0] + c[1]) + (c[2] + c[3])) + ((d[0] + d[1]) + (d[2] + d[3]));
    return rsqrtf(s * (1.0f / 1024.0f) + RMS_EPS);
}

template <int MODE> struct EpiRow {
    static constexpr bool PERM = true, AFTER_DRAIN = false;
    bf16_t* O; int ldc; const float* xsq; float* vsq; float qscale;
    __device__ __forceinline__ void operator()(const f32x4 (&acc)[2][2][4][2], const Unit& u, int wr, int wc, int fr, int fq) const {
        const int row0 = u.pm * BM + wr * 64 + fr, col0 = u.pn * BM + wc * 32 + 8 * fq;
        const int sec = u.pn >> 2;
        const float sc = (MODE == 0 && sec == 2) ? qscale : 1.0f;
#pragma unroll
        for (int ai = 0; ai < 2; ++ai)
#pragma unroll
            for (int m = 0; m < 4; ++m) {
                const int row = row0 + ai * HALF + m * 16;
                const float rs = rstd_from16(xsq + (size_t)row * 16) * sc;
                bf16_t* rowp = O + (size_t)row * ldc + col0;
                float vs = 0.f;
#pragma unroll
                for (int bj = 0; bj < 2; ++bj) {
                    const f32x4 v0 = acc[ai][bj][m][0] * rs, v1 = acc[ai][bj][m][1] * rs;
                    if (MODE == 0) vs += (v0[0] * v0[0] + v0[1] * v0[1]) + (v0[2] * v0[2] + v0[3] * v0[3]) + (v1[0] * v1[0] + v1[1] * v1[1]) + (v1[2] * v1[2] + v1[3] * v1[3]);
                    *(u32x4*)(rowp + bj * HALF) = pack8(v0, v1);
                }
                if (MODE == 0 && sec == 1) {
                    vs += __shfl_xor(vs, 16); vs += __shfl_xor(vs, 32);
                    if (fq == 0) vsq[(size_t)row * 16 + (u.pn - 4) * 4 + wc] = vs;
                }
            }
    }
};
template <int STEP> struct EpiGate {
    static constexpr bool PERM = true, AFTER_DRAIN = false;
    bf16_t* O; const bf16_t* G; int ldg;
    __device__ __forceinline__ void operator()(const f32x4 (&acc)[2][2][4][2], const Unit& u, int wr, int wc, int fr, int fq) const {
        const int row0 = u.pm * BM + wr * 64 + fr, col0 = u.pn * BM + wc * 32 + 8 * fq;
#pragma unroll
        for (int ai = 0; ai < 2; ++ai)
#pragma unroll
            for (int m = 0; m < 4; ++m) {
                const int row = row0 + ai * HALF + m * 16;
#pragma unroll
                for (int bj = 0; bj < 2; ++bj) {
                    const u32x4 gv = *(const u32x4*)(G + (size_t)row * ldg + col0 + bj * HALF);
                    bf16_t* op = O + (size_t)row * 1024 + col0 + bj * HALF;
                    f32x4 v0 = acc[ai][bj][m][0], v1 = acc[ai][bj][m][1];
                    v0[0] *= sigm(bflo(gv.x)); v0[1] *= sigm(bfhi(gv.x)); v0[2] *= sigm(bflo(gv.y)); v0[3] *= sigm(bfhi(gv.y));
                    v1[0] *= sigm(bflo(gv.z)); v1[1] *= sigm(bfhi(gv.z)); v1[2] *= sigm(bflo(gv.w)); v1[3] *= sigm(bfhi(gv.w));
                    if (STEP == 1) { const u32x4 ov = *(const u32x4*)op;
                        v0[0] += bflo(ov.x); v0[1] += bfhi(ov.x); v0[2] += bflo(ov.y); v0[3] += bfhi(ov.y);
                        v1[0] += bflo(ov.z); v1[1] += bfhi(ov.z); v1[2] += bflo(ov.w); v1[3] += bfhi(ov.w); }
                    *(u32x4*)op = pack8(v0, v1);
                }
            }
    }
};
struct EpiGate2 {
    static constexpr bool PERM = true, AFTER_DRAIN = false;
    bf16_t* O; const bf16_t* G; int ldg;
    __device__ __forceinline__ void operator()(const f32x4 (&acc)[2][2][4][2], const Unit& u, int wr, int wc, int fr, int fq) const {
        const int row0 = u.pm * BM + wr * 64 + fr, col0 = u.pn * BM + wc * 32 + 8 * fq;
        const bf16_t* Gw = G + u.w * 1024; const bool add = (u.w != 0);
#pragma unroll
        for (int ai = 0; ai < 2; ++ai)
#pragma unroll
            for (int m = 0; m < 4; ++m) {
                const int row = row0 + ai * HALF + m * 16;
#pragma unroll
                for (int bj = 0; bj < 2; ++bj) {
                    const u32x4 gv = *(const u32x4*)(Gw + (size_t)row * ldg + col0 + bj * HALF);
                    bf16_t* op = O + (size_t)row * 1024 + col0 + bj * HALF;
                    const bf16_t* gp_ = Gw + (size_t)row * ldg + col0 + bj * HALF;
                    u32x4 ov = *(const u32x4*)(add ? (const bf16_t*)op : gp_);
                    ov.x = add ? ov.x : 0u; ov.y = add ? ov.y : 0u; ov.z = add ? ov.z : 0u; ov.w = add ? ov.w : 0u;
                    f32x4 v0 = acc[ai][bj][m][0], v1 = acc[ai][bj][m][1];
                    v0[0] = v0[0] * sigm(bflo(gv.x)) + bflo(ov.x); v0[1] = v0[1] * sigm(bfhi(gv.x)) + bfhi(ov.x); v0[2] = v0[2] * sigm(bflo(gv.y)) + bflo(ov.y); v0[3] = v0[3] * sigm(bfhi(gv.y)) + bfhi(ov.y);
                    v1[0] = v1[0] * sigm(bflo(gv.z)) + bflo(ov.z); v1[1] = v1[1] * sigm(bfhi(gv.z)) + bfhi(ov.z); v1[2] = v1[2] * sigm(bflo(gv.w)) + bflo(ov.w); v1[3] = v1[3] * sigm(bfhi(gv.w)) + bfhi(ov.w);
                    *(u32x4*)op = pack8(v0, v1);
                }
            }
    }
};
template <int XIN, int XOUT> struct EpiResid {
    static constexpr bool PERM = true, AFTER_DRAIN = false;
    const float* xin; float* xout; bf16_t* xb; float* sq;
    __device__ __forceinline__ void operator()(const f32x4 (&acc)[2][2][4][2], const Unit& u, int wr, int wc, int fr, int fq) const {
        const int row0 = u.pm * BM + wr * 64 + fr, col0 = u.pn * BM + wc * 32 + 8 * fq;
#pragma unroll
        for (int ai = 0; ai < 2; ++ai)
#pragma unroll
            for (int m = 0; m < 4; ++m) {
                const int row = row0 + ai * HALF + m * 16;
                float s = 0.f;
#pragma unroll
                for (int bj = 0; bj < 2; ++bj) {
                    const size_t off = (size_t)row * 1024 + col0 + bj * HALF;
                    f32x4 a0, a1;
                    if (XIN == 0) { a0 = *(const f32x4*)(xin + off); a1 = *(const f32x4*)(xin + off + 4); }
                    else { const u32x4 xv = *(const u32x4*)(xb + off); a0 = (f32x4){bflo(xv.x), bfhi(xv.x), bflo(xv.y), bfhi(xv.y)}; a1 = (f32x4){bflo(xv.z), bfhi(xv.z), bflo(xv.w), bfhi(xv.w)}; }
                    const f32x4 v0 = acc[ai][bj][m][0] + a0, v1 = acc[ai][bj][m][1] + a1;
                    s += (v0[0] * v0[0] + v0[1] * v0[1]) + (v0[2] * v0[2] + v0[3] * v0[3]) + (v1[0] * v1[0] + v1[1] * v1[1]) + (v1[2] * v1[2] + v1[3] * v1[3]);
                    if (XOUT == 2) { *(f32x4*)(xout + off) = v0; *(f32x4*)(xout + off + 4) = v1; }
                    else *(u32x4*)(xb + off) = pack8(v0, v1);
                }
                s += __shfl_xor(s, 16); s += __shfl_xor(s, 32);
                if (fq == 0) sq[(size_t)row * 16 + u.pn * 4 + wc] = s;
            }
    }
};

__device__ __forceinline__ float dpp_ror1(float x) { return __builtin_bit_cast(float, __builtin_amdgcn_update_dpp(0, __builtin_bit_cast(int, x), 0x121, 0xF, 0xF, false)); }
__device__ __forceinline__ float dpp_rol1(float x) { return __builtin_bit_cast(float, __builtin_amdgcn_update_dpp(0, __builtin_bit_cast(int, x), 0x12F, 0xF, 0xF, false)); }
__device__ __forceinline__ float gelu_t(float x) { const float z = 0.7978845608028654f * (x + 0.044715f * x * x * x); return x * __builtin_amdgcn_rcpf(1.0f + __builtin_amdgcn_exp2f(-2.8853900817779268f * z)); }
__device__ __forceinline__ void ld8w(const float* p, float (&a)[8]) { const f32x4 t0 = *(const f32x4*)p, t1 = *(const f32x4*)(p + 4); a[0] = t0[0]; a[1] = t0[1]; a[2] = t0[2]; a[3] = t0[3]; a[4] = t1[0]; a[5] = t1[1]; a[6] = t1[2]; a[7] = t1[3]; }
typedef unsigned u32x2 __attribute__((ext_vector_type(2)));
__device__ __forceinline__ f32x4 dpp_ror1v(f32x4 x) { f32x4 r; r[0] = dpp_ror1(x[0]); r[1] = dpp_ror1(x[1]); r[2] = dpp_ror1(x[2]); r[3] = dpp_ror1(x[3]); return r; }
__device__ __forceinline__ f32x4 dpp_rol1v(f32x4 x) { f32x4 r; r[0] = dpp_rol1(x[0]); r[1] = dpp_rol1(x[1]); r[2] = dpp_rol1(x[2]); r[3] = dpp_rol1(x[3]); return r; }
__device__ __forceinline__ u32x2 pack4(const f32x4 a) { u32x2 w; w.x = cvt_pk_bf16(a[0], a[1]); w.y = cvt_pk_bf16(a[2], a[3]); return w; }
struct EpiConv {
    static constexpr bool PERM = true, AFTER_DRAIN = false; static constexpr int MROWS = 16384;
    bf16_t* HG; bf16_t* EDGE; const float* xsq; const float* cw; const float* cb;
    __device__ __forceinline__ void operator()(f32x4 (&acc)[2][2][4][2], const Unit& u, int wr, int wc, int fr, int fq) const {
        const int cola = u.pn * 128 + wc * 32 + 8 * fq;
        bf16_t* const TRASH = EDGE + (size_t)(MROWS / 64) * 4 * 5632 + ((size_t)blockIdx.x * 512 + threadIdx.x) * 8;
#pragma unroll
        for (int ai = 0; ai < 2; ++ai) {
            int rowb = u.pm * BM + ai * HALF + wr * 64;
            asm volatile("" : "+s"(rowb));
            float rs[4];
#pragma unroll
            for (int m = 0; m < 4; ++m) rs[m] = rstd_from16(xsq + (size_t)(rowb + m * 16 + fr) * 16);
#pragma unroll
            for (int hf = 1; hf >= 0; --hf)
#pragma unroll
                for (int n = 0; n < 2; ++n) {
                    int col = hf * 2816 + cola + 4 * n;
                    asm volatile("" : "+v"(col));
                    const f32x4 w0 = *(const f32x4*)(cw + col), w1 = *(const f32x4*)(cw + 5632 + col), w2 = *(const f32x4*)(cw + 2 * 5632 + col), bs = *(const f32x4*)(cb + col);
#pragma unroll
                    for (int m = 0; m < 4; ++m) acc[ai][hf][m][n] = acc[ai][hf][m][n] * rs[m];
                    { bf16_t* e0 = (fr < 2) ? EDGE + ((size_t)(rowb >> 6) * 4 + fr) * 5632 + col : TRASH;
                      bf16_t* e3 = (fr >= 14) ? EDGE + ((size_t)(rowb >> 6) * 4 + (fr - 12)) * 5632 + col : TRASH;
                      *(u32x2*)e0 = pack4(acc[ai][hf][0][n]); *(u32x2*)e3 = pack4(acc[ai][hf][3][n]); }
                    f32x4 rprev = {0.f, 0.f, 0.f, 0.f}, lm = dpp_rol1v(acc[ai][hf][0][n]);
#pragma unroll
                    for (int m = 0; m < 4; ++m) {
                        const f32x4 x = acc[ai][hf][m][n];
                        const f32x4 rm = dpp_ror1v(x);
                        f32x4 ln = {0.f, 0.f, 0.f, 0.f}; if (m < 3) ln = dpp_rol1v(acc[ai][hf][m < 3 ? m + 1 : 3][n]);
                        const f32x4 pv = (fr == 0) ? rprev : rm, nx = (fr == 15) ? ln : lm;
                        acc[ai][hf][m][n] = pv * w0 + x * w1 + nx * w2 + bs;
                        rprev = rm; lm = ln;
                    }
                    asm volatile("" ::: "memory"); __builtin_amdgcn_sched_barrier(0);
                }
#pragma unroll
            for (int m = 0; m < 4; ++m) {
                const bool skip = (m == 0 && fr == 0) || (m == 3 && fr == 15);
                int ro = (rowb + m * 16 + fr) * 2816 + cola;
                asm volatile("" : "+v"(ro));
#pragma unroll
                for (int n = 0; n < 2; ++n) {
                    f32x4 o;
#pragma unroll
                    for (int i = 0; i < 4; ++i) o[i] = gelu_t(acc[ai][0][m][n][i]) * acc[ai][1][m][n][i];
                    *(u32x2*)(skip ? TRASH : HG + (size_t)ro + 4 * n) = pack4(o);
                }
                asm volatile("" ::: "memory"); __builtin_amdgcn_sched_barrier(0);
            }
        }
    }
};

template <class Epi, class Sched, bool ALIGN_EPI = false, bool SP2 = false>
__device__ __forceinline__ void gemm_phase(PG8_LAS unsigned char* lds, const Gemm g, const Sched& S, const Epi& E) {
    const int tid = opaque_tid(), wid = __builtin_amdgcn_readfirstlane(tid >> 6), lane = tid & 63, wr = wid >> 2, wc = wid & 3, fr = lane & 15, fq = lane >> 4;
    const int K = g.K, nt = K / BK;
    unsigned voffA[2], voffB[2];
#pragma unroll
    for (int i = 0; i < 2; ++i) { int R, C; stage_rc(tid * 16 + i * 8192, R, C); const int Rb = Epi::PERM ? ((R & ~31) + perm32(R & 31)) : R;
        voffA[i] = (unsigned)(R * g.lda + C) * 2u; voffB[i] = (unsigned)(Rb * K + C) * 2u; }
    const size_t kstep = (size_t)(BK * 2);
    const size_t hstepA = (size_t)HALF * g.lda * 2, hstepB = (size_t)HALF * K * 2;
    const size_t tstepA = 2 * hstepA, tstepB = 2 * hstepB;
    const unsigned ldsw = (unsigned)wid * 1024u;
    const int aoff = lds_byte(wr * 64 + fr, fq * 8), boff = lds_byte(wc * 32 + fr, fq * 8);
#define PG8_SA(b, h) (((b) * 2 + (h)) * HTB)
#define PG8_SB(b, h) ((4 + (b) * 2 + (h)) * HTB)
#define PG8_STAGE(bufoff, gbase, voff) do { _Pragma("unroll") for (int _i = 0; _i < 2; ++_i) \
        __builtin_amdgcn_global_load_lds((const unsigned*)((const char*)(gbase) + (voff)[_i]), (PG8_LAS unsigned*)(lds + (bufoff) + ldsw + _i * 8192), 16, 0, 0); } while (0)
#define PG8_LDA(dst, b, h) do { _Pragma("unroll") for (int m = 0; m < 4; ++m) _Pragma("unroll") for (int k = 0; k < 2; ++k) dst[m][k] = *(const PG8_LAS bf16x8*)(lds + PG8_SA(b, h) + aoff + m * 2048 + k * 1024); } while (0)
#define PG8_LDB(dst, b, h) do { _Pragma("unroll") for (int n = 0; n < 2; ++n) _Pragma("unroll") for (int k = 0; k < 2; ++k) dst[n][k] = *(const PG8_LAS bf16x8*)(lds + PG8_SB(b, h) + boff + n * 2048 + k * 1024); } while (0)
#define PG8_MMA(ai, bj, At, Bt) do { __builtin_amdgcn_s_setprio(1); _Pragma("unroll") for (int m = 0; m < 4; ++m) _Pragma("unroll") for (int n = 0; n < 2; ++n) _Pragma("unroll") for (int k = 0; k < 2; ++k) \
        acc[ai][bj][m][n] = __builtin_amdgcn_mfma_f32_16x16x32_bf16(Bt[n][k], At[m][k], acc[ai][bj][m][n], 0, 0, 0); __builtin_amdgcn_s_setprio(0); } while (0)
#define PG8_WAIT_V(n) asm volatile("s_waitcnt vmcnt(" #n ")" ::: "memory")
#define PG8_WAIT_L(n) asm volatile("s_waitcnt lgkmcnt(" #n ")" ::: "memory")
#define PG8_BAR __builtin_amdgcn_s_barrier()
#define PG8_SCHED __builtin_amdgcn_sched_barrier(0)
    Unit cur, nxt; int ui = 0;
    if (!S.next(0, cur)) return;
    f32x4 acc[2][2][4][2];
#pragma unroll
    for (int a = 0; a < 2; ++a)
#pragma unroll
        for (int b = 0; b < 2; ++b)
#pragma unroll
            for (int m = 0; m < 4; ++m)
#pragma unroll
                for (int n = 0; n < 2; ++n) acc[a][b][m][n] = (f32x4){0.f, 0.f, 0.f, 0.f};
    bf16x8 At[4][2], B0[2][2], B1[2][2];
    const char* cA = (const char*)g.A + (size_t)cur.pm * tstepA + (size_t)cur.w * g.a2; const char* cB = (const char*)g.Bt + (size_t)cur.pn * tstepB + (size_t)cur.w * g.b2;
    S.a_ready(cur);
    if constexpr (SP2) {
        PG8_STAGE(PG8_SB(0, 0), cB, voffB); PG8_STAGE(PG8_SB(0, 1), cB + hstepB, voffB); PG8_STAGE(PG8_SA(0, 0), cA, voffA); PG8_STAGE(PG8_SA(0, 1), cA + hstepA, voffA);
        if (wr == 1) PG8_BAR;
        PG8_WAIT_V(2); PG8_BAR;
        PG8_STAGE(PG8_SB(1, 0), cB + kstep, voffB); PG8_STAGE(PG8_SA(1, 0), cA + kstep, voffA); PG8_STAGE(PG8_SB(1, 1), cB + hstepB + kstep, voffB);
        PG8_WAIT_V(6); PG8_BAR;
    } else {
        PG8_STAGE(PG8_SB(0, 0), cB, voffB); PG8_STAGE(PG8_SA(0, 0), cA, voffA); PG8_STAGE(PG8_SB(0, 1), cB + hstepB, voffB); PG8_STAGE(PG8_SA(0, 1), cA + hstepA, voffA);
        if (wr == 1) PG8_BAR;
        PG8_WAIT_V(4); PG8_BAR;
        PG8_STAGE(PG8_SB(1, 0), cB + kstep, voffB); PG8_STAGE(PG8_SA(1, 0), cA + kstep, voffA); PG8_STAGE(PG8_SB(1, 1), cB + hstepB + kstep, voffB);
        PG8_WAIT_V(6); PG8_BAR;
    }
    for (;;) {
        const bool has_next = S.next(ui + 1, nxt);
        const char* nA = has_next ? (const char*)g.A + (size_t)nxt.pm * tstepA + (size_t)nxt.w * g.a2 : cA; const char* nB = has_next ? (const char*)g.Bt + (size_t)nxt.pn * tstepB + (size_t)nxt.w * g.b2 : cB;
        for (int t = 0; t < nt; t += 2) {
            const bool last = (t == nt - 2);
            const char* a1 = cA + (size_t)(t + 1) * kstep;
            const char* a2 = last ? nA : cA + (size_t)(t + 2) * kstep; const char* b2 = last ? nB : cB + (size_t)(t + 2) * kstep;
            const char* a3 = a2 + kstep; const char* b3 = b2 + kstep;
            if (last && has_next) S.a_ready(nxt);
            if constexpr (SP2) {
            PG8_LDB(B0, 0, 0); PG8_LDB(B1, 0, 1); PG8_SCHED; PG8_LDA(At, 0, 0); PG8_STAGE(PG8_SA(1, 1), a1 + hstepA, voffA);
            PG8_WAIT_V(8); PG8_WAIT_L(0); PG8_BAR; PG8_MMA(0, 0, At, B0); PG8_MMA(0, 1, At, B1); PG8_BAR; PG8_SCHED;
            PG8_LDA(At, 0, 1); PG8_STAGE(PG8_SB(0, 0), b2, voffB); PG8_STAGE(PG8_SB(0, 1), b2 + hstepB, voffB); PG8_STAGE(PG8_SA(0, 0), a2, voffA);
            PG8_WAIT_V(8); PG8_WAIT_L(0); PG8_BAR; PG8_MMA(1, 0, At, B0); PG8_MMA(1, 1, At, B1); PG8_BAR; PG8_SCHED;
            PG8_LDB(B0, 1, 0); PG8_LDB(B1, 1, 1); PG8_SCHED; PG8_LDA(At, 1, 0); PG8_STAGE(PG8_SA(0, 1), a2 + hstepA, voffA);
            PG8_WAIT_V(8); PG8_WAIT_L(0); PG8_BAR; PG8_MMA(0, 0, At, B0); PG8_MMA(0, 1, At, B1); PG8_BAR; PG8_SCHED;
            PG8_LDA(At, 1, 1); PG8_STAGE(PG8_SB(1, 0), b3, voffB); PG8_STAGE(PG8_SB(1, 1), b3 + hstepB, voffB); PG8_STAGE(PG8_SA(1, 0), a3, voffA);
            PG8_WAIT_V(8); PG8_WAIT_L(0); PG8_BAR; PG8_MMA(1, 0, At, B0); PG8_MMA(1, 1, At, B1); PG8_BAR; PG8_SCHED;
            } else {
            PG8_LDB(B0, 0, 0); PG8_SCHED; PG8_LDA(At, 0, 0); PG8_STAGE(PG8_SA(1, 1), a1 + hstepA, voffA);
            PG8_WAIT_L(8); PG8_BAR; PG8_WAIT_L(0); PG8_MMA(0, 0, At, B0); PG8_BAR; PG8_SCHED;
            PG8_LDB(B1, 0, 1); PG8_STAGE(PG8_SB(0, 0), b2, voffB);
            PG8_BAR; PG8_WAIT_L(0); PG8_MMA(0, 1, At, B1); PG8_BAR;
            PG8_LDA(At, 0, 1); PG8_STAGE(PG8_SA(0, 0), a2, voffA);
            PG8_BAR; PG8_WAIT_L(0); PG8_MMA(1, 0, At, B0); PG8_BAR; PG8_SCHED;
            PG8_STAGE(PG8_SB(0, 1), b2 + hstepB, voffB);
            PG8_WAIT_V(6); PG8_BAR; PG8_MMA(1, 1, At, B1); PG8_BAR;
            PG8_LDB(B0, 1, 0); PG8_SCHED; PG8_LDA(At, 1, 0); PG8_STAGE(PG8_SA(0, 1), a2 + hstepA, voffA);
            PG8_WAIT_L(8); PG8_BAR; PG8_WAIT_L(0); PG8_MMA(0, 0, At, B0); PG8_BAR; PG8_SCHED;
            PG8_LDB(B1, 1, 1); PG8_STAGE(PG8_SB(1, 0), b3, voffB);
            PG8_BAR; PG8_WAIT_L(0); PG8_MMA(0, 1, At, B1); PG8_BAR;
            PG8_LDA(At, 1, 1); PG8_STAGE(PG8_SA(1, 0), a3, voffA);
            PG8_BAR; PG8_WAIT_L(0); PG8_MMA(1, 0, At, B0); PG8_BAR; PG8_SCHED;
            PG8_STAGE(PG8_SB(1, 1), b3 + hstepB, voffB);
            PG8_WAIT_V(6); PG8_BAR; PG8_MMA(1, 1, At, B1); PG8_BAR;
            }
        }
        if constexpr (ALIGN_EPI) { if (wr == 0) PG8_BAR; }
        if constexpr (!Epi::AFTER_DRAIN) { E(acc, cur, wr, wc, fr, fq); S.done(cur); }
        if (!has_next) break;
#pragma unroll
        for (int a = 0; a < 2; ++a)
#pragma unroll
            for (int b = 0; b < 2; ++b)
#pragma unroll
                for (int m = 0; m < 4; ++m)
#pragma unroll
                    for (int n = 0; n < 2; ++n) acc[a][b][m][n] = (f32x4){0.f, 0.f, 0.f, 0.f};
        cur = nxt; cA = nA; cB = nB; ++ui;
        if constexpr (ALIGN_EPI) { if (wr == 1) PG8_BAR; }
    }
    PG8_WAIT_V(0);
    if constexpr (!ALIGN_EPI) { if (wr == 0) PG8_BAR; }
    PG8_BAR;
    if constexpr (Epi::AFTER_DRAIN) { E.fused(acc, cur, wr, wc, fr, fq, lds, wid, lane); S.done(cur); }
#undef PG8_SA
#undef PG8_SB
#undef PG8_STAGE
#undef PG8_LDA
#undef PG8_LDB
#undef PG8_MMA
#undef PG8_WAIT_V
#undef PG8_WAIT_L
#undef PG8_BAR
#undef PG8_SCHED
}
}

#define LAS __attribute__((address_space(3)))
typedef unsigned short bf16;
typedef float f32x4 __attribute__((ext_vector_type(4)));
typedef float f32x16 __attribute__((ext_vector_type(16)));
typedef short bf16x8 __attribute__((ext_vector_type(8)));
typedef short s16x4 __attribute__((ext_vector_type(4)));
typedef unsigned u32x4 __attribute__((ext_vector_type(4)));
typedef unsigned u32x2 __attribute__((ext_vector_type(2)));

__device__ __forceinline__ float wave_sum(float v) {
#pragma unroll
    for (int o = 1; o < 64; o <<= 1) v += __shfl_xor(v, o);
    return v;
}
__device__ __forceinline__ unsigned f2bf(float f) { unsigned u = __builtin_bit_cast(unsigned, f); return (u + 0x7fffu + ((u >> 16) & 1u)) >> 16; }
__device__ __forceinline__ unsigned pk2(float lo, float hi) { return f2bf(lo) | (f2bf(hi) << 16); }
__device__ __forceinline__ unsigned cvtpk(float lo, float hi) { return pg8::cvt_pk_bf16(lo, hi); }
__device__ __forceinline__ int crow(int r, int hi) { return (r & 3) + 8 * (r >> 2) + 4 * hi; }
__device__ __forceinline__ float ex2(float x) { return __builtin_amdgcn_exp2f(x); }
__device__ __forceinline__ s16x4 trrd(const LAS unsigned char* p) { return __builtin_bit_cast(s16x4, __builtin_amdgcn_ds_read_tr16_b64_v4i16((LAS s16x4*)p)); }
#define XHALF(v, OP) ({ auto rr_ = __builtin_amdgcn_permlane32_swap(__float_as_uint(v), __float_as_uint(v), false, false); OP(__uint_as_float(rr_[0]), __uint_as_float(rr_[1])); })
__device__ __forceinline__ float fmax2(float a, float b) { return __builtin_fmaxf(a, b); }
__device__ __forceinline__ float fadd2(float a, float b) { return a + b; }

constexpr int DM = 1024, SEQ = 2048, DEPTH = 2, INC = 7168, DFF = 2816, DFF2 = 5632;
constexpr int MG = 16384, NGROUP = 3, MT = 49152;
constexpr int C_U = 0, C_VA = 1024, C_Q = 2048, C_K = 3072, C_VB = 4096, C_GA = 5120, C_GB = 6144;
constexpr float LOG2E = 1.4426950408889634f;

namespace att {
constexpr int KP = 272, VP = 320;
constexpr int L_K = 0, L_V = 2 * 64 * KP, L_B = L_V + 2 * 64 * VP, L_Q = L_B + 16384, L_WS = L_Q + 4 * 32 * KP, L_END = L_WS + 8 * 256;
constexpr int L_X = 0;
static_assert(4 * 64 * 64 * 4 <= L_B, "exchange buffer fits the rings");
constexpr float THR = 8.0f;
#define MFMA32(a, b, c) __builtin_amdgcn_mfma_f32_32x32x16_bf16((a), (b), (c), 0, 0, 0)
#define FMAX(a, b) __builtin_elementwise_maximum((a), (b))

#define T_TILE() do { f32x16 s0, s1; bf16x8 pw0, pw1, pw2, pw3; \
    if (coff != cprev) { cprev = coff; _Pragma("unroll") for (int r = 0; r < 16; ++r) negm[r] = coff - mref; }     \
    _Pragma("unroll") for (int d0_ = 0; d0_ < 4; ++d0_) { \
        const bf16x8 k0_ = *(const LAS bf16x8*)(kb + d0_ * 32); \
        const bf16x8 k1_ = *(const LAS bf16x8*)(kb + 32 * KP + d0_ * 32); \
        if (d0_ == 0) { s0 = MFMA32(k0_, qf[0], negm); s1 = MFMA32(k1_, qf[0], negm); } \
        else { s0 = MFMA32(k0_, qf[d0_], s0); s1 = MFMA32(k1_, qf[d0_], s1); } } \
    if (near) { _Pragma("unroll") for (int r = 0; r < 16; ++r) { s0[r] += bp[(r & 3) + 8 * (r >> 2)]; s1[r] += bp[32 + (r & 3) + 8 * (r >> 2)]; } } \
    float mx = FMAX(s0[0], s1[0]); \
    _Pragma("unroll") for (int r = 1; r < 16; ++r) mx = FMAX(mx, FMAX(s0[r], s1[r])); \
    mx = XHALF(mx, fmax2); \
    if (first || __any(mx > THR)) { \
        const float dl = first ? mx : FMAX(mx, 0.f), alpha = first ? 1.0f : ex2(-dl); mref += dl;     \
        _Pragma("unroll") for (int r = 0; r < 16; ++r) { s0[r] -= dl; s1[r] -= dl; negm[r] -= dl; } \
        if (hi == 0) wsf[r32] = alpha; \
        asm volatile("s_waitcnt lgkmcnt(0)" ::: "memory"); \
        _Pragma("unroll") for (int r = 0; r < 16; ++r) { const float al = wsf[crow(r, hi)]; osum[r] *= al; \
            _Pragma("unroll") for (int db = 0; db < 4; ++db) o[db][r] *= al; } \
        asm volatile("s_waitcnt lgkmcnt(0)" ::: "memory"); } \
    _Pragma("unroll") for (int r = 0; r < 16; ++r) { s0[r] = ex2(s0[r]); s1[r] = ex2(s1[r]); } \
    { u32x4 w; \
      w.x = cvtpk(s0[0], s0[1]); w.y = cvtpk(s0[2], s0[3]); w.z = cvtpk(s0[4], s0[5]); w.w = cvtpk(s0[6], s0[7]); pw0 = __builtin_bit_cast(bf16x8, w); \
      w.x = cvtpk(s0[8], s0[9]); w.y = cvtpk(s0[10], s0[11]); w.z = cvtpk(s0[12], s0[13]); w.w = cvtpk(s0[14], s0[15]); pw1 = __builtin_bit_cast(bf16x8, w); \
      w.x = cvtpk(s1[0], s1[1]); w.y = cvtpk(s1[2], s1[3]); w.z = cvtpk(s1[4], s1[5]); w.w = cvtpk(s1[6], s1[7]); pw2 = __builtin_bit_cast(bf16x8, w); \
      w.x = cvtpk(s1[8], s1[9]); w.y = cvtpk(s1[10], s1[11]); w.z = cvtpk(s1[12], s1[13]); w.w = cvtpk(s1[14], s1[15]); pw3 = __builtin_bit_cast(bf16x8, w); } \
    osum = MFMA32(pw0, ones, osum); osum = MFMA32(pw1, ones, osum); osum = MFMA32(pw2, ones, osum); osum = MFMA32(pw3, ones, osum);     \
    _Pragma("unroll") for (int db = 0; db < 4; ++db) { \
        const s16x4 a0 = trrd(vb + 0 * VP + db * 64), a1 = trrd(vb + 8 * VP + db * 64), a2 = trrd(vb + 16 * VP + db * 64), a3 = trrd(vb + 24 * VP + db * 64); \
        const s16x4 a4 = trrd(vb + 32 * VP + db * 64), a5 = trrd(vb + 40 * VP + db * 64), a6 = trrd(vb + 48 * VP + db * 64), a7 = trrd(vb + 56 * VP + db * 64); \
        o[db] = MFMA32(pw0, ((bf16x8){a0[0], a0[1], a0[2], a0[3], a1[0], a1[1], a1[2], a1[3]}), o[db]); \
        o[db] = MFMA32(pw1, ((bf16x8){a2[0], a2[1], a2[2], a2[3], a3[0], a3[1], a3[2], a3[3]}), o[db]); \
        o[db] = MFMA32(pw2, ((bf16x8){a4[0], a4[1], a4[2], a4[3], a5[0], a5[1], a5[2], a5[3]}), o[db]); \
        o[db] = MFMA32(pw3, ((bf16x8){a6[0], a6[1], a6[2], a6[3], a7[0], a7[1], a7[2], a7[3]}), o[db]); } } while (0)

#define TILE_CLASS(t) (((t) * 64 - (qw0 + 31) >= 128) ? 1 : ((qw0 - ((t) * 64 + 63) >= 128) ? -1 : 0))

__device__ __forceinline__ void attn_unit(LAS unsigned char* lds, bf16* proj, int b, int h, int qb, const float* tbh, const float* lq, int layer, const float* subg) {
    const int tid = opaque_tid(), lane = tid & 63, r32 = lane & 31, hi = lane >> 5;
    const int wid = __builtin_amdgcn_readfirstlane(tid >> 6), qg = wid & 3, mp = wid >> 2;
    LAS float* bl = (LAS float*)(lds + L_B);
#pragma unroll
    for (int i = 0; i < 2; ++i) ((LAS f32x4*)bl)[tid + 512 * i] = ((const f32x4*)tbh)[tid + 512 * i];
    const float cpos = __uint_as_float(__builtin_amdgcn_readfirstlane(__float_as_uint(tbh[4095]))), cneg = __uint_as_float(__builtin_amdgcn_readfirstlane(__float_as_uint(tbh[1])));
    const size_t rowbase = (size_t)b * SEQ;
    const int qw0 = qb * 128 + qg * 32, qpos = qw0 + r32;
    const LAS float* blq = bl + (2048 - qpos + 4 * hi);
    LAS float* wsf = (LAS float*)(lds + L_WS + wid * 256);
    bf16x8 qf[4];
    { const bf16* Qg = proj + (rowbase + qpos) * INC + C_Q + h * 128 + mp * 64 + hi * 8;
#pragma unroll
      for (int d0 = 0; d0 < 4; ++d0) qf[d0] = *(const bf16x8*)(Qg + d0 * 16); }
    const int srow = tid >> 4, scc = tid & 15;
    const bf16* kg0 = proj + (rowbase + srow) * INC + C_K + h * 128 + scc * 8;
    const bf16* vg0 = proj + (rowbase + srow) * INC + C_VB + h * 128 + scc * 8;
    LAS unsigned char* kdst = lds + L_K + srow * KP + scc * 16;
    LAS unsigned char* vdst = lds + L_V + srow * VP + scc * 16;
    const LAS unsigned char* kb0 = lds + L_K + r32 * KP + mp * 128 + hi * 16;
    const LAS unsigned char* vb0 = lds + L_V + (4 * hi + ((lane >> 2) & 3)) * VP + (((lane >> 4) & 1) * 16 + (lane & 3) * 4) * 2;
    u32x4 kr[2], vr[2];
#define LOADK(t) do { _Pragma("unroll") for (int i = 0; i < 2; ++i) kr[i] = *(const u32x4*)(kg0 + (size_t)((t) * 64 + i * 32) * INC); } while (0)
#define LOADV(t) do { _Pragma("unroll") for (int i = 0; i < 2; ++i) vr[i] = *(const u32x4*)(vg0 + (size_t)((t) * 64 + i * 32) * INC); } while (0)
#define STOREK(buf) do { _Pragma("unroll") for (int i = 0; i < 2; ++i) *(LAS u32x4*)(kdst + (buf) * 64 * KP + i * 32 * KP) = kr[i]; } while (0)
#define STOREV(buf) do { _Pragma("unroll") for (int i = 0; i < 2; ++i) *(LAS u32x4*)(vdst + (buf) * 64 * VP + i * 32 * VP) = vr[i]; } while (0)
    float mref = 0.f, cprev = 0.f;
    f32x16 negm;
#pragma unroll
    for (int r = 0; r < 16; ++r) negm[r] = 0.f;
    f32x16 o[4], osum;
    const bf16x8 ones = {0x3F80, 0x3F80, 0x3F80, 0x3F80, 0x3F80, 0x3F80, 0x3F80, 0x3F80};
#pragma unroll
    for (int r = 0; r < 16; ++r) osum[r] = 0.f;
#pragma unroll
    for (int i = 0; i < 4; ++i)
#pragma unroll
        for (int r = 0; r < 16; ++r) o[i][r] = 0.f;
    LOADK(0); LOADV(0); STOREK(0); STOREV(0); LOADK(1); LOADV(1);
    __syncthreads();
    for (int t = 0; t < 32; ++t) {
        const int buf = t & 1;
        if (t + 1 < 32) { STOREK(buf ^ 1); STOREV(buf ^ 1); }
        if (t + 2 < 32) { LOADK(t + 2); LOADV(t + 2); }
        const LAS unsigned char* kb = kb0 + buf * 64 * KP;
        const LAS unsigned char* vb = vb0 + buf * 64 * VP;
        const int tc = TILE_CLASS(t);
        const bool near = (tc == 0), first = (t == 0); const LAS float* bp = blq + t * 64; const float coff = near ? 0.f : (tc > 0 ? cpos : cneg);
        T_TILE();
        __syncthreads();
    }
    float pa = lq[lane] * lq[64 + lane], pb = lq[128 + lane] * lq[192 + lane];
    pa = wave_sum(pa); pb = wave_sum(pb);
    const float lam = __expf(pa) - __expf(pb) + __uint_as_float(layer ? 0x3EB60549u : 0x3E4CCCCDu);
    { const float num = (mp == 0) ? 1.0f : lam;
#pragma unroll
      for (int r = 0; r < 16; ++r) { const float al = num * __builtin_amdgcn_rcpf(osum[r]);
#pragma unroll
          for (int db = 0; db < 4; ++db) o[db][r] *= al; } }
    LAS float* xb = (LAS float*)(lds + L_X) + qg * 4096 + lane;
    if (mp == 1) {
#pragma unroll
        for (int db = 0; db < 4; ++db)
#pragma unroll
            for (int r = 0; r < 16; ++r) xb[(db * 16 + r) * 64] = o[db][r];
    }
    __syncthreads();
    if (mp == 0) {
        float gsc[4];
        const float oml = __uint_as_float(layer ? 0x3F24FD5Cu : 0x3F4CCCCDu);
#pragma unroll
        for (int db = 0; db < 4; ++db) gsc[db] = subg[db * 32 + r32] * oml;
        bf16* Op = proj + (rowbase + qw0) * INC + C_Q + h * 128 + r32;
#pragma unroll
        for (int r = 0; r < 16; ++r) {
            float ov[4];
#pragma unroll
            for (int db = 0; db < 4; ++db) ov[db] = o[db][r] - xb[(db * 16 + r) * 64];
            float ss = (ov[0] * ov[0] + ov[1] * ov[1]) + (ov[2] * ov[2] + ov[3] * ov[3]);
#pragma unroll
            for (int of = 1; of < 32; of <<= 1) ss += __shfl_xor(ss, of);
            const float rs = rsqrtf(ss * (1.0f / 128.0f) + 1e-6f);
            bf16* op = Op + (size_t)crow(r, hi) * INC;
#pragma unroll
            for (int db = 0; db < 4; ++db) op[db * 32] = (bf16)f2bf(ov[db] * rs * gsc[db]);
        }
    }
    asm volatile("s_waitcnt lgkmcnt(0)" ::: "memory");
#undef LOADK
#undef LOADV
#undef STOREK
#undef STOREV
}
}

namespace sgu {
constexpr int VP = 320, L_R = 128 * VP;
__device__ __forceinline__ void sgu_unit(LAS unsigned char* lds, bf16* proj, int n, int g, const float* W, const float* bvec, const float* gch, const float* vsq) {
    const int tid = opaque_tid(), lane = tid & 63, r32 = lane & 31, hi = lane >> 5;
    const int wid = __builtin_amdgcn_readfirstlane(tid >> 6);
    LAS float* rl = (LAS float*)(lds + L_R);
    const size_t row0 = (size_t)n * 128;
    const int tblk = wid >> 1, cb0 = 2 * (wid & 1);
    u32x4 vt[4];
#pragma unroll
    for (int i = 0; i < 4; ++i) { const int c = tid + 512 * i, row = c >> 4, cc = c & 15; vt[i] = *(const u32x4*)(proj + (row0 + row) * INC + C_VA + g * 128 + cc * 8); }
    float rsv = 0.f; if (tid < 128) rsv = pg8::rstd_from16(vsq + (row0 + tid) * 16);
    const float* Wr = W + (size_t)(tblk * 32 + r32) * 128 + hi * 4;
    f32x4 wv[8][2];
#pragma unroll
    for (int ks = 0; ks < 8; ++ks) { wv[ks][0] = *(const f32x4*)(Wr + ks * 16); wv[ks][1] = *(const f32x4*)(Wr + ks * 16 + 8); }
    float bt[16], gs[2]; bf16 uv[2][16];
#pragma unroll
    for (int r = 0; r < 16; ++r) bt[r] = bvec[tblk * 32 + crow(r, hi)];
    bf16* ubase = proj + row0 * INC + C_U + g * 128 + cb0 * 32 + r32;
#pragma unroll
    for (int c = 0; c < 2; ++c) { gs[c] = gch[(cb0 + c) * 32 + r32];
#pragma unroll
        for (int r = 0; r < 16; ++r) uv[c][r] = ubase[(size_t)(tblk * 32 + crow(r, hi)) * INC + c * 32]; }
#pragma unroll
    for (int i = 0; i < 4; ++i) { const int c = tid + 512 * i, row = c >> 4, cc = c & 15; *(LAS u32x4*)(lds + row * VP + cc * 16) = vt[i]; }
    if (tid < 128) rl[tid] = rsv;
    __syncthreads();
    f32x16 acc[2];
#pragma unroll
    for (int c = 0; c < 2; ++c)
#pragma unroll
        for (int r = 0; r < 16; ++r) acc[c][r] = 0.f;
    const LAS unsigned char* vb = lds + (4 * hi + ((lane >> 2) & 3)) * VP + (((lane >> 4) & 1) * 16 + (lane & 3) * 4) * 2;
#pragma unroll
    for (int ks = 0; ks < 8; ++ks) {
        const f32x4 r0 = *(const LAS f32x4*)(rl + ks * 16 + hi * 4), r1 = *(const LAS f32x4*)(rl + ks * 16 + hi * 4 + 8);
        const f32x4 a0 = wv[ks][0] * r0, a1 = wv[ks][1] * r1;
        const bf16x8 af = __builtin_bit_cast(bf16x8, pg8::pack8(a0, a1));
#pragma unroll
        for (int c = 0; c < 2; ++c) {
            const s16x4 lo = trrd(vb + (16 * ks) * VP + (cb0 + c) * 64), hh = trrd(vb + (16 * ks + 8) * VP + (cb0 + c) * 64);
            const bf16x8 vf = (bf16x8){lo[0], lo[1], lo[2], lo[3], hh[0], hh[1], hh[2], hh[3]};
            acc[c] = MFMA32(af, vf, acc[c]);
        }
    }
#pragma unroll
    for (int c = 0; c < 2; ++c)
#pragma unroll
        for (int r = 0; r < 16; ++r) {
            const float u = __uint_as_float((unsigned)uv[c][r] << 16);
            ubase[(size_t)(tblk * 32 + crow(r, hi)) * INC + c * 32] = (bf16)f2bf(u * (gs[c] * acc[c][r] + bt[r]));
        }
    __syncthreads();
}
__device__ __forceinline__ void sgu_phase(LAS unsigned char* lds, bf16* proj, int vcu, int G, const float* Wl, const float* bl, const float* gl, const float* vsq) {
    const int tid = opaque_tid(), lane = tid & 63, r32 = lane & 31, hi = lane >> 5;
    const int wid = __builtin_amdgcn_readfirstlane(tid >> 6);
    const int nun = (1024 - vcu + G - 1) / G;
    if (nun <= 0) return;
    constexpr int VBUF = 128 * VP;
    LAS float* rl = (LAS float*)(lds + 2 * VBUF);
    const int tblk = wid >> 1, cb0 = 2 * (wid & 1);
    const LAS unsigned char* vb0 = lds + (4 * hi + ((lane >> 2) & 3)) * VP + (((lane >> 4) & 1) * 16 + (lane & 3) * 4) * 2;
    f32x4 wv[8][2]; float bt[16], gs[2]; int gprev = -1;
    u32x4 vtN[4]; float rsN = 0.f; bf16 uC[2][16];
#define SGU_LOAD(id_) do { const int n_ = (id_) >> 3, g_ = (id_) & 7; const size_t row0_ = (size_t)n_ * 128; \
        _Pragma("unroll") for (int i_ = 0; i_ < 4; ++i_) { const int c_ = tid + 512 * i_, row_ = c_ >> 4, cc_ = c_ & 15; vtN[i_] = *(const u32x4*)(proj + (row0_ + row_) * INC + C_VA + g_ * 128 + cc_ * 8); } \
        if (tid < 128) rsN = pg8::rstd_from16(vsq + (row0_ + tid) * 16); } while (0)
#define SGU_STAGE(b_) do { _Pragma("unroll") for (int i_ = 0; i_ < 4; ++i_) { const int c_ = tid + 512 * i_, row_ = c_ >> 4, cc_ = c_ & 15; *(LAS u32x4*)(lds + (b_) * VBUF + row_ * VP + cc_ * 16) = vtN[i_]; } \
        if (tid < 128) rl[(b_) * 128 + tid] = rsN; } while (0)
    SGU_LOAD(vcu);
    SGU_STAGE(0);
    for (int i = 0; i < nun; ++i) {
        const int id = i * G + vcu, n = id >> 3, g = id & 7, b = i & 1;
        if (g != gprev) {
            gprev = g;
            const float* Wr = Wl + (size_t)g * 128 * 128 + (size_t)(tblk * 32 + r32) * 128 + hi * 4;
#pragma unroll
            for (int ks = 0; ks < 8; ++ks) { wv[ks][0] = *(const f32x4*)(Wr + ks * 16); wv[ks][1] = *(const f32x4*)(Wr + ks * 16 + 8); }
#pragma unroll
            for (int r = 0; r < 16; ++r) bt[r] = bl[g * 128 + tblk * 32 + crow(r, hi)];
#pragma unroll
            for (int c = 0; c < 2; ++c) gs[c] = gl[g * 128 + (cb0 + c) * 32 + r32];
        }
        __syncthreads();
        const bool more = (i + 1 < nun);
        if (more) SGU_LOAD(id + G);
        bf16* ubase = proj + (size_t)n * 128 * INC + C_U + g * 128 + (size_t)(tblk * 32) * INC + cb0 * 32;
        const unsigned uoff = (unsigned)(4 * hi) * INC + r32;
#pragma unroll
        for (int c = 0; c < 2; ++c)
#pragma unroll
            for (int r = 0; r < 16; ++r) uC[c][r] = (ubase + (size_t)((r & 3) + 8 * (r >> 2)) * INC + c * 32)[uoff];
        f32x16 acc[2];
#pragma unroll
        for (int c = 0; c < 2; ++c)
#pragma unroll
            for (int r = 0; r < 16; ++r) acc[c][r] = 0.f;
        const LAS unsigned char* vb = vb0 + b * VBUF; const LAS float* rlb = rl + b * 128;
#pragma unroll
        for (int ks = 0; ks < 8; ++ks) {
            const f32x4 r0 = *(const LAS f32x4*)(rlb + ks * 16 + hi * 4), r1 = *(const LAS f32x4*)(rlb + ks * 16 + hi * 4 + 8);
            const f32x4 a0 = wv[ks][0] * r0, a1 = wv[ks][1] * r1;
            const bf16x8 af = __builtin_bit_cast(bf16x8, pg8::pack8(a0, a1));
#pragma unroll
            for (int c = 0; c < 2; ++c) {
                const s16x4 lo = trrd(vb + (16 * ks) * VP + (cb0 + c) * 64), hh = trrd(vb + (16 * ks + 8) * VP + (cb0 + c) * 64);
                const bf16x8 vf = (bf16x8){lo[0], lo[1], lo[2], lo[3], hh[0], hh[1], hh[2], hh[3]};
                acc[c] = MFMA32(af, vf, acc[c]);
            }
        }
#pragma unroll
        for (int c = 0; c < 2; ++c)
#pragma unroll
            for (int r = 0; r < 16; ++r) {
                const float u = __uint_as_float((unsigned)uC[c][r] << 16);
                (ubase + (size_t)((r & 3) + 8 * (r >> 2)) * INC + c * 32)[uoff] = (bf16)f2bf(u * (gs[c] * acc[c][r] + bt[r]));
            }
        if (more) SGU_STAGE(b ^ 1);
    }
    __syncthreads();
#undef SGU_LOAD
#undef SGU_STAGE
}
}

constexpr size_t MiB = 1u << 20;
constexpr size_t WS_BAR = 512 * 1024, BAR_BYTES = 16384;
constexpr size_t WS_TB = 0, WS_VSQ = 1 * MiB, WS_XSQ = 2 * MiB, WS_WIN = 6 * MiB, WS_WBR = 34 * MiB, WS_WOUT = 42 * MiB, WS_WUP = 46 * MiB, WS_WDN = 68 * MiB;
constexpr size_t WS_XB = 80 * MiB, WS_PROJ = 176 * MiB, WS_MRG = 400 * MiB, WS_END = 488 * MiB;
static_assert(WS_WIN + (size_t)DEPTH * INC * DM * 2 <= WS_WBR && WS_WUP + (size_t)DEPTH * DFF2 * DM * 2 <= WS_WDN && WS_WDN + (size_t)DEPTH * DM * DFF * 2 <= WS_XB, "weights map");
static_assert(WS_XB + (size_t)MT * DM * 2 <= WS_PROJ && WS_PROJ + (size_t)MG * INC * 2 <= WS_MRG && WS_MRG + (size_t)MG * DFF * 2 <= WS_END, "activation map");
constexpr int LDS_BYTES = 163840;
static_assert(att::L_END <= LDS_BYTES, "attention LDS map");
constexpr int NWAVES = 8, NTHREADS = 512;
constexpr int NPH = 1 + NGROUP * 12 + 1;
constexpr int LDS_BAR_OFF = LDS_BYTES - 64;

__device__ __forceinline__ void transpose_item(const float* W, const float* gk, int K, int N, bf16* WT, LAS float* scr, int item, int lane, bool perm_up = false) {
    const int nblk = N / 32, kb = item / nblk, nb = item % nblk, k0 = 64 * kb, n0 = 32 * nb;
    const int nd0 = !perm_up ? n0 : (n0 < 2816 ? 256 * (n0 / 128) + n0 % 128 : 256 * ((n0 - 2816) / 128) + 128 + (n0 - 2816) % 128);
#pragma unroll 8
    for (int i = 0; i < 32; ++i) { const int kk = 2 * i + (lane >> 5); const float sc = gk ? gk[k0 + kk] : 1.0f; scr[kk * 33 + (lane & 31)] = W[(size_t)(k0 + kk) * N + n0 + (lane & 31)] * sc; }
    asm volatile("s_waitcnt lgkmcnt(0)" ::: "memory");
    const int c = lane & 7;
#pragma unroll
    for (int j = 0; j < 4; ++j) { const int n = (lane >> 3) + 8 * j; const LAS float* s = scr + (8 * c) * 33 + n;
        u32x4 o; o.x = pk2(s[0 * 33], s[1 * 33]); o.y = pk2(s[2 * 33], s[3 * 33]); o.z = pk2(s[4 * 33], s[5 * 33]); o.w = pk2(s[6 * 33], s[7 * 33]);
        *(u32x4*)(WT + (size_t)(nd0 + n) * K + k0 + 8 * c) = o; }
    asm volatile("s_waitcnt lgkmcnt(0)" ::: "memory");
}
__device__ __forceinline__ int rel_bucket(int rel) {
    const int n = rel < 0 ? -rel : rel;
    const int large = 8 + (n >= 12) + (n >= 16) + (n >= 23) + (n >= 32) + (n >= 46) + (n >= 64) + (n >= 91);
    return (rel > 0 ? 16 : 0) + (n < 8 ? n : large);
}
__device__ __forceinline__ void ld8(const bf16* p, float (&a)[8]) {
    const u32x4 v = *(const u32x4*)p;
    a[0] = pg8::bflo(v.x); a[1] = pg8::bfhi(v.x); a[2] = pg8::bflo(v.y); a[3] = pg8::bfhi(v.y); a[4] = pg8::bflo(v.z); a[5] = pg8::bfhi(v.z); a[6] = pg8::bflo(v.w); a[7] = pg8::bfhi(v.w);
}
__device__ __forceinline__ void ld8f(const float* p, float (&a)[8]) {
    const f32x4 v0 = *(const f32x4*)p, v1 = *(const f32x4*)(p + 4);
    a[0] = v0[0]; a[1] = v0[1]; a[2] = v0[2]; a[3] = v0[3]; a[4] = v1[0]; a[5] = v1[1]; a[6] = v1[2]; a[7] = v1[3];
}
__device__ __forceinline__ float gelu_tanh(float x) {
    const float z = 0.7978845608028654f * (x + 0.044715f * x * x * x);
    return x * __builtin_amdgcn_rcpf(1.0f + __builtin_amdgcn_exp2f(-2.0f * LOG2E * z));
}
__device__ __forceinline__ void conv_gate_phase(const bf16* __restrict__ up, bf16* __restrict__ hg, const float* __restrict__ cw, const float* __restrict__ cbias, int gtid, int gthreads) {
    constexpr int R = 16, NCH = DFF / 8;
    const int nitems = (MG / R) * NCH;
    for (int it = gtid; it < nitems; it += gthreads) {
        const int rb = it / NCH, ch = it - rb * NCH, col = ch * 8, row0 = rb * R, t0 = row0 & (SEQ - 1);
        float wa[3][8], wb[3][8], ba[8], bb[8];
#pragma unroll
        for (int j = 0; j < 3; ++j) { ld8f(cw + (size_t)j * DFF2 + col, wa[j]); ld8f(cw + (size_t)j * DFF2 + DFF + col, wb[j]); }
        ld8f(cbias + col, ba); ld8f(cbias + DFF + col, bb);
        float pa[8], pb[8], ca[8], cb[8];
        const bf16* urow = up + (size_t)row0 * DFF2 + col;
        if (t0 == 0) {
#pragma unroll
            for (int e = 0; e < 8; ++e) { pa[e] = 0.f; pb[e] = 0.f; }
        } else { ld8(urow - DFF2, pa); ld8(urow - DFF2 + DFF, pb); }
        ld8(urow, ca); ld8(urow + DFF, cb);
#pragma unroll 1
        for (int r0 = 0; r0 < R; r0 += 4) {
            u32x4 ra[4], rb[4];
#pragma unroll
            for (int j = 0; j < 4; ++j) {
                if (t0 + r0 + j + 1 == SEQ) { ra[j] = (u32x4){0u, 0u, 0u, 0u}; rb[j] = (u32x4){0u, 0u, 0u, 0u}; }
                else { ra[j] = *(const u32x4*)(urow + (size_t)(r0 + j + 1) * DFF2); rb[j] = *(const u32x4*)(urow + (size_t)(r0 + j + 1) * DFF2 + DFF); }
            }
#pragma unroll
            for (int j = 0; j < 4; ++j) {
                float na[8], nb[8], o[8];
                na[0] = pg8::bflo(ra[j].x); na[1] = pg8::bfhi(ra[j].x); na[2] = pg8::bflo(ra[j].y); na[3] = pg8::bfhi(ra[j].y); na[4] = pg8::bflo(ra[j].z); na[5] = pg8::bfhi(ra[j].z); na[6] = pg8::bflo(ra[j].w); na[7] = pg8::bfhi(ra[j].w);
                nb[0] = pg8::bflo(rb[j].x); nb[1] = pg8::bfhi(rb[j].x); nb[2] = pg8::bflo(rb[j].y); nb[3] = pg8::bfhi(rb[j].y); nb[4] = pg8::bflo(rb[j].z); nb[5] = pg8::bfhi(rb[j].z); nb[6] = pg8::bflo(rb[j].w); nb[7] = pg8::bfhi(rb[j].w);
#pragma unroll
                for (int e = 0; e < 8; ++e) {
                    const float va = pa[e] * wa[0][e] + ca[e] * wa[1][e] + na[e] * wa[2][e] + ba[e];
                    const float vb = pb[e] * wb[0][e] + cb[e] * wb[1][e] + nb[e] * wb[2][e] + bb[e];
                    o[e] = gelu_tanh(va) * vb;
                }
                u32x4 w; w.x = cvtpk(o[0], o[1]); w.y = cvtpk(o[2], o[3]); w.z = cvtpk(o[4], o[5]); w.w = cvtpk(o[6], o[7]);
                *(u32x4*)(hg + (size_t)(row0 + r0 + j) * DFF + col) = w;
#pragma unroll
                for (int e = 0; e < 8; ++e) { pa[e] = ca[e]; pb[e] = cb[e]; ca[e] = na[e]; cb[e] = nb[e]; }
            }
        }
    }
}

#define XB_TMO      128
#define XB_XCNT(j)  (256  + 64 * (j))
#define XB_XSUB(j)  (1280 + 64 * (j))
#define XB_XGEN(j)  (2304 + 64 * (j))
#define XB_TOP      3328
#define XB_TOPGEN   3392
#define XCD_BAR_WORDS 3456
#define XB_SPIN_CAP (1u << 18)

__device__ __forceinline__ unsigned xb_ld(unsigned* p)              { return __hip_atomic_load(p, __ATOMIC_RELAXED, __HIP_MEMORY_SCOPE_AGENT); }
__device__ __forceinline__ unsigned xb_add(unsigned* p, unsigned v) { return __hip_atomic_fetch_add(p, v, __ATOMIC_RELAXED, __HIP_MEMORY_SCOPE_AGENT); }
__device__ __forceinline__ unsigned xb_xcc_id() { return (unsigned)__builtin_amdgcn_s_getreg((3 << 11) | 20) & 0xFu; }
#define XB_SPIN(cond, bar) do { unsigned _sp = 0; while (cond) { __builtin_amdgcn_s_sleep(1); \
    if ((++_sp & 255u) == 0u) { if (xb_ld(&(bar)[XB_TMO])) break; if (_sp > XB_SPIN_CAP) { atomicAdd(&(bar)[XB_TMO], 1u); break; } } } } while (0)

struct XcdBarrier {
    unsigned* bar; unsigned x;
    volatile LAS unsigned* st;
};

__device__ __forceinline__ XcdBarrier xcd_barrier_post(unsigned* bar, volatile LAS unsigned* st) {
    XcdBarrier b; b.bar = bar; b.x = xb_xcc_id(); b.st = st;
    if (threadIdx.x == 0) (void)xb_add(&bar[XB_XCNT(b.x)], 1u);
    return b;
}
__device__ __forceinline__ void xcd_barrier_complete(unsigned* bar, unsigned x, unsigned& nloc, unsigned& nx) {
    const unsigned G = gridDim.x * gridDim.y * gridDim.z;
    unsigned sum, cnt, mine, sp = 0u;
    for (;;) {
        sum = 0u; cnt = 0u; mine = 0u;
#pragma unroll
        for (unsigned j = 0; j < 16; ++j) { const unsigned c = xb_ld(&bar[XB_XCNT(j)]); sum += c; cnt += (c > 0u) ? 1u : 0u; mine = (j == x) ? c : mine; }
        if (sum == G) break;
        __builtin_amdgcn_s_sleep(1);
        if ((++sp & 255u) == 0u) { if (xb_ld(&bar[XB_TMO])) break; if (sp > XB_SPIN_CAP) { atomicAdd(&bar[XB_TMO], 1u); break; } }
    }
    nloc = mine > 0u ? mine : 1u; nx = cnt > 0u ? cnt : 1u;
}

__device__ __forceinline__ void xcd_barrier(const XcdBarrier& b) {
    asm volatile("s_waitcnt vmcnt(0)" ::: "memory");
    __syncthreads();
    if (threadIdx.x == 0) {
        unsigned* bar = b.bar;
        __builtin_amdgcn_s_waitcnt(0);
        unsigned nloc = b.st[0], nx = b.st[1];
        if (nloc == 0u) { xcd_barrier_complete(bar, b.x, nloc, nx); b.st[0] = nloc; b.st[1] = nx; }
        const unsigned old = xb_add(&bar[XB_XSUB(b.x)], 1u);
        const unsigned gen = old / nloc;
        if (old + 1u == (gen + 1u) * nloc) {
            __builtin_amdgcn_fence(__ATOMIC_RELEASE, "agent");
            asm volatile("s_waitcnt vmcnt(0)" ::: "memory");
            const unsigned og = xb_add(&bar[XB_TOP], 1u);
            const unsigned tg = og / nx;
            if (og + 1u == (tg + 1u) * nx) xb_add(&bar[XB_TOPGEN], 1u);
            else XB_SPIN(xb_ld(&bar[XB_TOPGEN]) == tg, bar);
            __builtin_amdgcn_fence(__ATOMIC_ACQUIRE, "agent");
            xb_add(&bar[XB_XGEN(b.x)], 1u);
            asm volatile("s_waitcnt vmcnt(0)" ::: "memory");
        } else {
            XB_SPIN(xb_ld(&bar[XB_XGEN(b.x)]) == gen, bar);
            __builtin_amdgcn_fence(__ATOMIC_ACQUIRE, "agent");
            asm volatile("s_waitcnt vmcnt(0)" ::: "memory");
        }
    }
    __syncthreads();
}

__device__ __forceinline__ void conv_edge_fixup(const bf16* __restrict__ EDGE, bf16* __restrict__ hg, const float* __restrict__ cw, const float* __restrict__ cbias, int pm, int tid) {
    constexpr int NCH = DFF / 8;
    for (int it = tid; it < 8 * NCH; it += NTHREADS) {
        const int rsel = it / NCH, ch = it - rsel * NCH, col = ch * 8, bq = rsel >> 1, hiRow = rsel & 1;
        const int blk = pm * 4 + bq, row = blk * 64 + (hiRow ? 63 : 0), t = row & (SEQ - 1);
        const bf16* pc = EDGE + ((size_t)blk * 4 + (hiRow ? 3 : 0)) * DFF2 + col;
        const bf16* pp = (hiRow ? EDGE + ((size_t)blk * 4 + 2) * DFF2 : EDGE + ((size_t)(blk - 1) * 4 + 3) * DFF2) + col;
        const bf16* pn = (hiRow ? EDGE + ((size_t)(blk + 1) * 4 + 0) * DFF2 : EDGE + ((size_t)blk * 4 + 1) * DFF2) + col;
        const bool zp = (!hiRow && t == 0), zn = (hiRow && t == SEQ - 1);
        float pa[8], pb[8], ca[8], cb[8], na[8], nb[8];
        if (zp) {
#pragma unroll
            for (int e = 0; e < 8; ++e) { pa[e] = 0.f; pb[e] = 0.f; }
        } else { ld8(pp, pa); ld8(pp + DFF, pb); }
        if (zn) {
#pragma unroll
            for (int e = 0; e < 8; ++e) { na[e] = 0.f; nb[e] = 0.f; }
        } else { ld8(pn, na); ld8(pn + DFF, nb); }
        ld8(pc, ca); ld8(pc + DFF, cb);
        float o[8];
#pragma unroll
        for (int hf = 0; hf < 2; ++hf) {
            float w0[8], w1[8], w2[8], bs[8];
            ld8f(cw + hf * DFF + col, w0); ld8f(cw + DFF2 + hf * DFF + col, w1); ld8f(cw + 2 * DFF2 + hf * DFF + col, w2); ld8f(cbias + hf * DFF + col, bs);
#pragma unroll
            for (int e = 0; e < 8; ++e) {
                if (hf == 0) o[e] = gelu_tanh(pa[e] * w0[e] + ca[e] * w1[e] + na[e] * w2[e] + bs[e]);
                else o[e] *= pb[e] * w0[e] + cb[e] * w1[e] + nb[e] * w2[e] + bs[e];
            }
        }
        u32x4 w; w.x = cvtpk(o[0], o[1]); w.y = cvtpk(o[2], o[3]); w.z = cvtpk(o[4], o[5]); w.w = cvtpk(o[6], o[7]);
        *(u32x4*)(hg + (size_t)row * DFF + col) = w;
    }
}

__device__ __forceinline__ void final_norm_group(float* xres, const float* xsq_g, const float* gfin, int gw, int NGW, int lane) {
    for (int m = gw; m < MG; m += NGW) {
        const float rs = pg8::rstd_from16(xsq_g + (size_t)m * 16);
        f32x4* xr = (f32x4*)(xres + (size_t)m * DM) + lane; const f32x4* gr = (const f32x4*)gfin + lane;
#pragma unroll
        for (int j = 0; j < 4; ++j) xr[64 * j] = xr[64 * j] * rs * gr[64 * j];
    }
}

struct Args { const float* in[18]; float* out; unsigned char* ws; int ph_lo, ph_hi; };
static_assert(sizeof(Args) == 168, "Args layout");

__global__ void __launch_bounds__(NTHREADS) mk_fwd(Args a) {
    extern __shared__ __attribute__((aligned(16))) unsigned char lds_raw[];
    LAS unsigned char* lds = (LAS unsigned char*)lds_raw;
    cg::grid_group grid = cg::this_grid();
    const int G = gridDim.x, bx = blockIdx.x;
    const int vcu = __builtin_amdgcn_readfirstlane((G % 8 == 0) ? (bx % 8) * (G / 8) + bx / 8 : bx);
    const __attribute__((address_space(4))) unsigned char* ka = (const __attribute__((address_space(4))) unsigned char*)__builtin_amdgcn_kernarg_segment_ptr();
    const int ph_lo = *(const __attribute__((address_space(4))) int*)(ka + 160), ph_hi = *(const __attribute__((address_space(4))) int*)(ka + 164);
    if (threadIdx.x < 16) ((LAS unsigned*)(lds + LDS_BAR_OFF))[threadIdx.x] = 0u;
    __syncthreads();
    XcdBarrier xbar = xcd_barrier_post((unsigned*)(*(unsigned char* const __attribute__((address_space(4)))*)(ka + 152) + WS_BAR), (volatile LAS unsigned*)(lds + LDS_BAR_OFF));
    unsigned long long tacc = 0ull;
    for (int ph = ph_lo; ph < ph_hi; ++ph) {
        unsigned long long tp0 = 0ull; int pclass = 0, lastk = -1; if (PROBE) tp0 = __builtin_amdgcn_s_memrealtime();
        const int tid = opaque_tid(), lane = tid & 63, wave = __builtin_amdgcn_readfirstlane(tid >> 6);
        const __attribute__((address_space(4))) unsigned char* kp = ka; asm volatile("" : "+s"(kp));
#define KARG_F(i) (*(const float* const __attribute__((address_space(4)))*)(kp + 8 * (i)))
        unsigned char* ws = *(unsigned char* const __attribute__((address_space(4)))*)(kp + 152);
        float* const outp = *(float* const __attribute__((address_space(4)))*)(kp + 144);
        float* tb = (float*)(ws + WS_TB); float* vsq = (float*)(ws + WS_VSQ); float* xsq = (float*)(ws + WS_XSQ);
        bf16* Win_t = (bf16*)(ws + WS_WIN); bf16* Wbr_t = (bf16*)(ws + WS_WBR); bf16* Wout_t = (bf16*)(ws + WS_WOUT); bf16* Wup_t = (bf16*)(ws + WS_WUP); bf16* Wdn_t = (bf16*)(ws + WS_WDN);
        bf16* xb = (bf16*)(ws + WS_XB); bf16* proj = (bf16*)(ws + WS_PROJ); bf16* upb = (bf16*)(ws + WS_PROJ); bf16* mrg = (bf16*)(ws + WS_MRG); bf16* hg = (bf16*)(ws + WS_MRG);
#define x_prompt KARG_F(0)
#define x_sample KARG_F(1)
#define rel_bias KARG_F(2)
#define g_mix KARG_F(3)
#define w_in KARG_F(4)
#define sgu_g KARG_F(5)
#define sgu_w KARG_F(6)
#define sgu_b KARG_F(7)
#define lam_qk KARG_F(8)
#define sub_g KARG_F(9)
#define w_br KARG_F(10)
#define w_out KARG_F(11)
#define g_ffn KARG_F(12)
#define w_up KARG_F(13)
#define conv_w KARG_F(14)
#define conv_b KARG_F(15)
#define w_down KARG_F(16)
#define g_final KARG_F(17)

        if (ph == 0) { if EN(7) {
            LAS float* scr = (LAS float*)(lds + wave * 16384);
            const int gw = vcu * NWAVES + wave, NGW = G * NWAVES;
            constexpr int I_IN = (DM / 64) * (INC / 32), I_SQ = (DM / 64) * (DM / 32), I_UP = (DM / 64) * (DFF2 / 32), I_DN = (DFF / 64) * (DM / 32);
            constexpr int I_L = I_IN + 3 * I_SQ + I_UP + I_DN;
            for (int it = gw; it < DEPTH * I_L; it += NGW) {
                const int l = it / I_L; int r = it - l * I_L;
                if (r < I_IN) { transpose_item(w_in + (size_t)l * DM * INC, g_mix + l * DM, DM, INC, Win_t + (size_t)l * INC * DM, scr, r, lane); continue; } r -= I_IN;
                if (r < 2 * I_SQ) { const int j = r / I_SQ; transpose_item(w_br + (size_t)(l * 2 + j) * DM * DM, nullptr, DM, DM, Wbr_t + (size_t)(l * 2 + j) * DM * DM, scr, r - j * I_SQ, lane); continue; } r -= 2 * I_SQ;
                if (r < I_SQ) { transpose_item(w_out + (size_t)l * DM * DM, nullptr, DM, DM, Wout_t + (size_t)l * DM * DM, scr, r, lane); continue; } r -= I_SQ;
                if (r < I_UP) { transpose_item(w_up + (size_t)l * DM * DFF2, g_ffn + l * DM, DM, DFF2, Wup_t + (size_t)l * DFF2 * DM, scr, r, lane, true); continue; } r -= I_UP;
                transpose_item(w_down + (size_t)l * DFF * DM, nullptr, DFF, DM, Wdn_t + (size_t)l * DM * DFF, scr, r, lane);
            }
            for (int i = bx * NTHREADS + tid; i < 8 * 4096; i += G * NTHREADS) { const int h = i >> 12, rel = (i & 4095) - 2048; tb[i] = rel_bias[rel_bucket(rel) * 8 + h] * LOG2E; }
            for (int m = gw; m < MT; m += NGW) {
                const float* src = (m < MG) ? x_prompt + (size_t)m * DM : x_sample + (size_t)(m - MG) * DM;
                const f32x4* xr = (const f32x4*)src + lane;
                f32x4 v[4]; float s = 0.f;
#pragma unroll
                for (int j = 0; j < 4; ++j) { v[j] = xr[64 * j]; s += (v[j][0] * v[j][0] + v[j][1] * v[j][1]) + (v[j][2] * v[j][2] + v[j][3] * v[j][3]); }
                s = wave_sum(s);
                u32x2* o8 = (u32x2*)(xb + (size_t)m * DM) + lane;
#pragma unroll
                for (int j = 0; j < 4; ++j) { u32x2 w; w.x = cvtpk(v[j][0], v[j][1]); w.y = cvtpk(v[j][2], v[j][3]); o8[64 * j] = w; }
                if (lane < 16) xsq[(size_t)m * 16 + lane] = (lane == 0) ? s : 0.f;
            }
        } } else {
            const int q = ph - 1; const bool last = (q == NGROUP * 12); const int g = last ? NGROUP - 1 : q / 12, k15 = last ? 14 : q % 12;
            const size_t grow0 = (size_t)g * MG;
            const float* xin_g = (g == 0) ? x_prompt : x_sample + (size_t)(g - 1) * MG * DM;
            float* xres = outp + grow0 * DM; bf16* xb_g = xb + grow0 * DM; float* xsq_g = xsq + grow0 * 16;
            if (k15 == 14) { if EN(8) { final_norm_group(xres, xsq_g, g_final, vcu * NWAVES + wave, G * NWAVES, lane);
            } } else {
                const int l = k15 / 6, k = k15 % 6;
                pclass = (k == 1) ? 1 : 2; lastk = k;
                if (k == 0) { if EN(0) {
                    if (l == 0 && g > 0) final_norm_group(outp + (grow0 - MG) * DM, xsq + (grow0 - MG) * 16, g_final, vcu * NWAVES + wave, G * NWAVES, lane);
                    pg8::Gemm gm{xb_g, Win_t + (size_t)l * INC * DM, DM, INC, DM, MG}; pg8::RotOrder S; S.init(MG, INC, G, bx, 20);
                    pg8::EpiRow<0> E{proj, INC, xsq_g, vsq, 0.125f * LOG2E};
                    pg8::gemm_phase<pg8::EpiRow<0>, pg8::RotOrder, true, true>(lds, gm, S, E);
                } } else if (k == 1) { if EN(1) {
#ifndef NO_ATT
                    for (int i = 0; ; ++i) { int bh, qb; if (G == 256) { if (i >= 4) break; const int j = vcu & 31; bh = (vcu >> 5) * 8 + (j & 7); qb = 4 * i + (j >> 3); } else { const int id = i * G + vcu; if (id >= 1024) break; bh = id >> 4; qb = id & 15; }
                        att::attn_unit(lds, proj, bh >> 3, bh & 7, qb, tb + (bh & 7) * 4096, lam_qk + l * 256, l, sub_g + l * 128); __syncthreads(); }
#endif
                    if (PROBE == 5) tp0 = __builtin_amdgcn_s_memrealtime();
#ifndef NO_SGU
                    sgu::sgu_phase(lds, proj, vcu, G, sgu_w + (size_t)l * 8 * 128 * 128, sgu_b + l * 8 * 128, sgu_g + l * DM, vsq);
#endif
                    if (PROBE == 5) { pclass = 5; }
                } } else if (k == 2) { if EN(2) {
                    pg8::Gemm gm{proj + C_U, Wbr_t + (size_t)(l * 2) * DM * DM, INC, DM, DM, MG, (size_t)(C_Q - C_U) * 2, (size_t)DM * DM * 2}; pg8::PairOrder S; S.init(MG, DM, G, bx);
                    pg8::EpiGate2 E{mrg, proj + C_GA, INC};
                    pg8::gemm_phase<pg8::EpiGate2, pg8::PairOrder, true, true>(lds, gm, S, E);
                } } else if (k == 3) { if EN(3) {
                    pg8::Gemm gm{mrg, Wout_t + (size_t)l * DM * DM, DM, DM, DM, MG}; pg8::StaticOrder S; S.init(MG, DM, G, bx);
                    if (l == 0) { pg8::EpiResid<0, 1> E{xin_g, nullptr, xb_g, xsq_g}; pg8::gemm_phase<pg8::EpiResid<0, 1>, pg8::StaticOrder, true, true>(lds, gm, S, E); }
                    else { pg8::EpiResid<1, 1> E{nullptr, nullptr, xb_g, xsq_g}; pg8::gemm_phase<pg8::EpiResid<1, 1>, pg8::StaticOrder, true, true>(lds, gm, S, E); }
                } } else if (k == 4) { if EN(4) {
                    pg8::Gemm gm{xb_g, Wup_t + (size_t)l * DFF2 * DM, DM, DFF2, DM, MG}; pg8::StaticOrder S; S.init(MG, DFF2, G, bx);
                    pg8::EpiConv E{hg, (bf16*)(ws + WS_PROJ), xsq_g, conv_w + (size_t)l * 3 * DFF2, conv_b + (size_t)l * DFF2};
                    pg8::gemm_phase<pg8::EpiConv, pg8::StaticOrder, true, true>(lds, gm, S, E);
                } } else { if EN(6) {
                    { pg8::StaticOrder S0; S0.init(MG, DM, G, bx); pg8::Unit u0;
                      for (int i = 0; S0.next(i, u0); ++i) conv_edge_fixup((const bf16*)(ws + WS_PROJ), hg, conv_w + (size_t)l * 3 * DFF2, conv_b + (size_t)l * DFF2, u0.pm, tid);
                      asm volatile("s_waitcnt vmcnt(0)" ::: "memory"); __syncthreads(); }
                    pg8::Gemm gm{hg, Wdn_t + (size_t)l * DM * DFF, DFF, DM, DFF, MG}; pg8::StaticOrder S; S.init(MG, DM, G, bx);
                    if (l == 0) { pg8::EpiResid<1, 1> E{nullptr, nullptr, xb_g, xsq_g}; pg8::gemm_phase<pg8::EpiResid<1, 1>, pg8::StaticOrder, true, true>(lds, gm, S, E); }
                    else { pg8::EpiResid<1, 2> E{nullptr, xres, xb_g, xsq_g}; pg8::gemm_phase<pg8::EpiResid<1, 2>, pg8::StaticOrder, true, true>(lds, gm, S, E); }
                } }
            }
        }
        if (PROBE) { const unsigned long long tp1 = __builtin_amdgcn_s_memrealtime(); if (pclass == PROBE || (PROBE >= 10 && PROBE < 16 && lastk == PROBE - 10)) tacc += tp1 - tp0; tp0 = tp1; }
        if (ph + 1 < ph_hi) { if (ph == ph_lo) grid.sync(); else xcd_barrier(xbar); }
        if (PROBE == 4) tacc += __builtin_amdgcn_s_memrealtime() - tp0;
    }
    if (PROBE && bx == 0) { const unsigned long long te = __builtin_amdgcn_s_memrealtime() + tacc; while (__builtin_amdgcn_s_memrealtime() < te) __builtin_amdgcn_s_sleep(16); }
}

extern "C" void kernel_launch(void* const* d_in, const int* in_sizes, int n_in, void* d_out, int out_size, void* d_ws, size_t ws_size, hipStream_t stream) {
    static int grid = 0;
    if (grid == 0) {
        if (n_in != 18 || in_sizes[0] != MG * DM || in_sizes[1] != 2 * MG * DM || out_size != MT * DM || ws_size < WS_END) {
            fprintf(stderr, "kernel_launch: unexpected shapes (n_in %d, ws %zu); nothing launched\n", n_in, ws_size); grid = -1; return; }
        int dev = 0, cus = 0, per_cu = 0;
        hipGetDevice(&dev); hipDeviceGetAttribute(&cus, hipDeviceAttributeMultiprocessorCount, dev);
        if (hipFuncSetAttribute((const void*)mk_fwd, hipFuncAttributeMaxDynamicSharedMemorySize, LDS_BYTES) != hipSuccess) { fprintf(stderr, "kernel_launch: hipFuncSetAttribute failed\n"); grid = -1; return; }
        if (hipOccupancyMaxActiveBlocksPerMultiprocessor(&per_cu, (const void*)mk_fwd, NTHREADS, LDS_BYTES) != hipSuccess || per_cu < 1) { per_cu = 1; (void)hipGetLastError(); }
        grid = cus * 1;
        if (grid <= 0) { grid = -1; return; }
    }
    if (grid < 0) return;
    if (hipMemsetAsync((char*)d_ws + WS_BAR, 0, BAR_BYTES, stream) != hipSuccess) { fprintf(stderr, "kernel_launch: memset of the barrier words failed\n"); return; }
    Args a{};
    for (int i = 0; i < 18; ++i) a.in[i] = (const float*)d_in[i];
    a.out = (float*)d_out; a.ws = (unsigned char*)d_ws;
#if MK_SINGLE
    a.ph_lo = 0; a.ph_hi = NPH;
    void* args[] = {&a};
    hipError_t e = hipLaunchCooperativeKernel((const void*)mk_fwd, dim3(grid), dim3(NTHREADS), args, LDS_BYTES, stream);
    if (e != hipSuccess) fprintf(stderr, "cooperative launch failed: %s (grid %d)\n", hipGetErrorString(e), grid);
#else
    for (int ph = 0; ph < NPH; ++ph) { a.ph_lo = ph; a.ph_hi = ph + 1; hipLaunchKernelGGL(mk_fwd, dim3(grid), dim3(NTHREADS), LDS_BYTES, stream, a); }
#endif
}
```

```cpp
#include <hip/hip_runtime.h>
#include <hip/hip_cooperative_groups.h>
#include <cstdio>
#include <cstdint>
namespace cg = cooperative_groups;

#ifndef EN_MASK
#define EN_MASK 0x1ff
#endif
#define EN(k) constexpr ((EN_MASK >> (k)) & 1)
#ifndef PROBE
#define PROBE 0
#endif
#ifndef MK_SINGLE
#define MK_SINGLE 1
#endif

__device__ __forceinline__ int opaque_tid() { int t = threadIdx.x; asm volatile("" : "+v"(t)); return t; }
namespace pg8 {
#define PG8_LAS __attribute__((address_space(3)))
typedef unsigned short bf16_t;
typedef short bf16x8 __attribute__((ext_vector_type(8)));
typedef float f32x4 __attribute__((ext_vector_type(4)));
typedef unsigned u32x4 __attribute__((ext_vector_type(4)));
constexpr int BM = 256, BK = 64, HALF = 128, HTB = HALF * BK * 2  , STAGE_BYTES = 8 * HTB, NXCD = 8, WGM = 8;

__host__ __device__ __forceinline__ int lds_byte(int r, int c) { const int st = (r >> 4) * 2 + (c >> 5), rr = r & 15, cc = c & 31, ob = rr * 64 + cc * 2; return st * 1024 + (ob ^ (((ob >> 9) & 1) << 5)); }
__host__ __device__ __forceinline__ void stage_rc(int b, int& R, int& C) { const int st = b / 1024, sb = b % 1024, swz = sb ^ (((sb >> 9) & 1) << 5); R = (st >> 1) * 16 + swz / 64; C = (st & 1) * 32 + (swz % 64) / 2; }
__host__ __device__ __forceinline__ int perm32(int rho) { const int n = rho >> 4, i = rho & 15; return 8 * (i >> 2) + 4 * n + (i & 3); }

struct Unit { int pm, pn, w; };
struct Gemm { const bf16_t* A; const bf16_t* Bt; int lda, N, K, M; size_t a2, b2; };

struct StaticOrder {
    int nM, nN, nwg, G, c;
    __host__ __device__ void init(int M, int N, int G_, int c_) { nM = M / BM; nN = N / BM; nwg = nM * nN; G = G_; c = c_; }
    __host__ __device__ bool next(int i, Unit& u) const {
        const long L = (long)i * G + c; if (L >= nwg) return false;
        int wgid = (int)L; { const int q = nwg / NXCD, r = nwg % NXCD, xcd = wgid % NXCD, off = wgid / NXCD; wgid = (xcd < r ? xcd * (q + 1) : r * (q + 1) + (xcd - r) * q) + off; }
        const int nig = WGM * nN, gid = wgid / nig, fm = gid * WGM, gsz = (nM - fm) < WGM ? (nM - fm) : WGM;
        u.pm = fm + ((wgid % nig) % gsz); u.pn = (wgid % nig) / gsz; u.w = 0; return true;
    }
    __device__ __forceinline__ void a_ready(const Unit&) const {}
    __device__ __forceinline__ void done(const Unit&) const {}
};

struct PairOrder {
    StaticOrder base;
    __host__ __device__ void init(int M, int N, int G_, int c_) { base.init(M, N, G_, c_); }
    __host__ __device__ bool next(int i, Unit& u) const { if (!base.next(i >> 1, u)) return false; u.w = i & 1; return true; }
    __device__ __forceinline__ void a_ready(const Unit&) const {}
    __device__ __forceinline__ void done(const Unit&) const {}
};

__device__ __forceinline__ unsigned cvt_pk_bf16(float lo, float hi) { unsigned r; asm volatile("v_cvt_pk_bf16_f32 %0, %1, %2" : "=v"(r) : "v"(lo), "v"(hi)); return r; }
__device__ __forceinline__ float bflo(unsigned w) { return __uint_as_float(w << 16); }
__device__ __forceinline__ float bfhi(unsigned w) { return __uint_as_float(w & 0xffff0000u); }
__device__ __forceinline__ u32x4 pack8(const f32x4 a, const f32x4 b) { u32x4 w; w.x = cvt_pk_bf16(a[0], a[1]); w.y = cvt_pk_bf16(a[2], a[3]); w.z = cvt_pk_bf16(b[0], b[1]); w.w = cvt_pk_bf16(b[2], b[3]); return w; }
__device__ __forceinline__ float sigm(float x) { return __builtin_amdgcn_rcpf(1.0f + __builtin_amdgcn_exp2f(-1.4426950408889634f * x)); }
constexpr float RMS_EPS = 1e-6f;
__device__ __forceinline__ float rstd_from16(const float* p) {
    const f32x4 a = *(const f32x4*)p, b = *(const f32x4*)(p + 4), c = *(const f32x4*)(p + 8), d = *(const f32x4*)(p + 12);
    const float s = ((a[0] + a[1]) + (a[2] + a[3])) + ((b[0] + b[1]) + (b[2] + b[3])) + ((c[0] + c[1]) + (c[2] + c[3])) + ((d[0] + d[1]) + (d[2] + d[3]));
    return rsqrtf(s * (1.0f / 1024.0f) + RMS_EPS);
}

template <int MODE> struct EpiRow {
    static constexpr bool PERM = true, AFTER_DRAIN = false, CARRY = false;
    bf16_t* O; int ldc; const float* xsq; float* vsq; float qscale;
    __device__ __forceinline__ void operator()(const f32x4 (&acc)[2][2][4][2], const Unit& u, int wr, int wc, int fr, int fq) const {
        const int row0 = u.pm * BM + wr * 64 + fr, col0 = u.pn * BM + wc * 32 + 8 * fq;
        const int sec = u.pn >> 2;
        const float sc = (MODE == 0 && sec == 2) ? qscale : 1.0f;
#pragma unroll
        for (int ai = 0; ai < 2; ++ai)
#pragma unroll
            for (int m = 0; m < 4; ++m) {
                const int row = row0 + ai * HALF + m * 16;
                const float rs = rstd_from16(xsq + (size_t)row * 16) * sc;
                bf16_t* rowp = O + (size_t)row * ldc + col0;
                float vs = 0.f;
#pragma unroll
                for (int bj = 0; bj < 2; ++bj) {
                    const f32x4 v0 = acc[ai][bj][m][0] * rs, v1 = acc[ai][bj][m][1] * rs;
                    if (MODE == 0) vs += (v0[0] * v0[0] + v0[1] * v0[1]) + (v0[2] * v0[2] + v0[3] * v0[3]) + (v1[0] * v1[0] + v1[1] * v1[1]) + (v1[2] * v1[2] + v1[3] * v1[3]);
                    *(u32x4*)(rowp + bj * HALF) = pack8(v0, v1);
                }
                if (MODE == 0 && sec == 1) {
                    vs += __shfl_xor(vs, 16); vs += __shfl_xor(vs, 32);
                    if (fq == 0) vsq[(size_t)row * 16 + (u.pn - 4) * 4 + wc] = vs;
                }
            }
    }
};
template <int STEP> struct EpiGate {
    static constexpr bool PERM = true, AFTER_DRAIN = false, CARRY = false;
    bf16_t* O; const bf16_t* G; int ldg;
    __device__ __forceinline__ void operator()(const f32x4 (&acc)[2][2][4][2], const Unit& u, int wr, int wc, int fr, int fq) const {
        const int row0 = u.pm * BM + wr * 64 + fr, col0 = u.pn * BM + wc * 32 + 8 * fq;
#pragma unroll
        for (int ai = 0; ai < 2; ++ai)
#pragma unroll
            for (int m = 0; m < 4; ++m) {
                const int row = row0 + ai * HALF + m * 16;
#pragma unroll
                for (int bj = 0; bj < 2; ++bj) {
                    const u32x4 gv = *(const u32x4*)(G + (size_t)row * ldg + col0 + bj * HALF);
                    bf16_t* op = O + (size_t)row * 1024 + col0 + bj * HALF;
                    f32x4 v0 = acc[ai][bj][m][0], v1 = acc[ai][bj][m][1];
                    v0[0] *= sigm(bflo(gv.x)); v0[1] *= sigm(bfhi(gv.x)); v0[2] *= sigm(bflo(gv.y)); v0[3] *= sigm(bfhi(gv.y));
                    v1[0] *= sigm(bflo(gv.z)); v1[1] *= sigm(bfhi(gv.z)); v1[2] *= sigm(bflo(gv.w)); v1[3] *= sigm(bfhi(gv.w));
                    if (STEP == 1) { const u32x4 ov = *(const u32x4*)op;
                        v0[0] += bflo(ov.x); v0[1] += bfhi(ov.x); v0[2] += bflo(ov.y); v0[3] += bfhi(ov.y);
                        v1[0] += bflo(ov.z); v1[1] += bfhi(ov.z); v1[2] += bflo(ov.w); v1[3] += bfhi(ov.w); }
                    *(u32x4*)op = pack8(v0, v1);
                }
            }
    }
};
struct EpiGate2 {
    static constexpr bool PERM = true, AFTER_DRAIN = false, CARRY = false;
    bf16_t* O; const bf16_t* G; int ldg;
    __device__ __forceinline__ void operator()(const f32x4 (&acc)[2][2][4][2], const Unit& u, int wr, int wc, int fr, int fq) const {
        const int row0 = u.pm * BM + wr * 64 + fr, col0 = u.pn * BM + wc * 32 + 8 * fq;
        const bf16_t* Gw = G + u.w * 1024; const bool add = (u.w != 0);
#pragma unroll
        for (int ai = 0; ai < 2; ++ai)
#pragma unroll
            for (int m = 0; m < 4; ++m) {
                const int row = row0 + ai * HALF + m * 16;
#pragma unroll
                for (int bj = 0; bj < 2; ++bj) {
                    const u32x4 gv = *(const u32x4*)(Gw + (size_t)row * ldg + col0 + bj * HALF);
                    bf16_t* op = O + (size_t)row * 1024 + col0 + bj * HALF;
                    const bf16_t* gp_ = Gw + (size_t)row * ldg + col0 + bj * HALF;
                    u32x4 ov = *(const u32x4*)(add ? (const bf16_t*)op : gp_);
                    ov.x = add ? ov.x : 0u; ov.y = add ? ov.y : 0u; ov.z = add ? ov.z : 0u; ov.w = add ? ov.w : 0u;
                    f32x4 v0 = acc[ai][bj][m][0], v1 = acc[ai][bj][m][1];
                    v0[0] = v0[0] * sigm(bflo(gv.x)) + bflo(ov.x); v0[1] = v0[1] * sigm(bfhi(gv.x)) + bfhi(ov.x); v0[2] = v0[2] * sigm(bflo(gv.y)) + bflo(ov.y); v0[3] = v0[3] * sigm(bfhi(gv.y)) + bfhi(ov.y);
                    v1[0] = v1[0] * sigm(bflo(gv.z)) + bflo(ov.z); v1[1] = v1[1] * sigm(bfhi(gv.z)) + bfhi(ov.z); v1[2] = v1[2] * sigm(bflo(gv.w)) + bflo(ov.w); v1[3] = v1[3] * sigm(bfhi(gv.w)) + bfhi(ov.w);
                    *(u32x4*)op = pack8(v0, v1);
                }
            }
    }
};
struct EpiGate3 {
    static constexpr bool PERM = true, AFTER_DRAIN = false, CARRY = true;
    bf16_t* O; const bf16_t* G; int ldg;
    static __device__ __forceinline__ float em(float g) { return __builtin_amdgcn_exp2f(-1.4426950408889634f * g); }
    static __device__ __forceinline__ float emc(float g) { return __builtin_fminf(__builtin_amdgcn_exp2f(-1.4426950408889634f * g), 1e30f); }
    __device__ __forceinline__ void operator()(f32x4 (&acc)[2][2][4][2], const Unit& u, int wr, int wc, int fr, int fq) const {
        const int row0 = u.pm * BM + wr * 64 + fr, col0 = u.pn * BM + wc * 32 + 8 * fq;
        if (u.w == 0) {
#pragma unroll
            for (int ai = 0; ai < 2; ++ai)
#pragma unroll
                for (int m = 0; m < 4; ++m) {
                    const int row = row0 + ai * HALF + m * 16;
#pragma unroll
                    for (int bj = 0; bj < 2; ++bj) {
                        const bf16_t* gp = G + (size_t)row * ldg + col0 + bj * HALF;
                        const u32x4 ga = *(const u32x4*)gp, gb = *(const u32x4*)(gp + 1024);
                        f32x4& v0 = acc[ai][bj][m][0]; f32x4& v1 = acc[ai][bj][m][1];
                        v0[0] *= (1.0f + emc(bflo(gb.x))) * __builtin_amdgcn_rcpf(1.0f + em(bflo(ga.x))); v0[1] *= (1.0f + emc(bfhi(gb.x))) * __builtin_amdgcn_rcpf(1.0f + em(bfhi(ga.x)));
                        v0[2] *= (1.0f + emc(bflo(gb.y))) * __builtin_amdgcn_rcpf(1.0f + em(bflo(ga.y))); v0[3] *= (1.0f + emc(bfhi(gb.y))) * __builtin_amdgcn_rcpf(1.0f + em(bfhi(ga.y)));
                        v1[0] *= (1.0f + emc(bflo(gb.z))) * __builtin_amdgcn_rcpf(1.0f + em(bflo(ga.z))); v1[1] *= (1.0f + emc(bfhi(gb.z))) * __builtin_amdgcn_rcpf(1.0f + em(bfhi(ga.z)));
                        v1[2] *= (1.0f + emc(bflo(gb.w))) * __builtin_amdgcn_rcpf(1.0f + em(bflo(ga.w))); v1[3] *= (1.0f + emc(bfhi(gb.w))) * __builtin_amdgcn_rcpf(1.0f + em(bfhi(ga.w)));
                    }
                }
        } else {
#pragma unroll
            for (int ai = 0; ai < 2; ++ai)
#pragma unroll
                for (int m = 0; m < 4; ++m) {
                    const int row = row0 + ai * HALF + m * 16;
#pragma unroll
                    for (int bj = 0; bj < 2; ++bj) {
                        const u32x4 gb = *(const u32x4*)(G + 1024 + (size_t)row * ldg + col0 + bj * HALF);
                        f32x4 v0 = acc[ai][bj][m][0], v1 = acc[ai][bj][m][1];
                        v0[0] *= __builtin_amdgcn_rcpf(1.0f + emc(bflo(gb.x))); v0[1] *= __builtin_amdgcn_rcpf(1.0f + emc(bfhi(gb.x))); v0[2] *= __builtin_amdgcn_rcpf(1.0f + emc(bflo(gb.y))); v0[3] *= __builtin_amdgcn_rcpf(1.0f + emc(bfhi(gb.y)));
                        v1[0] *= __builtin_amdgcn_rcpf(1.0f + emc(bflo(gb.z))); v1[1] *= __builtin_amdgcn_rcpf(1.0f + emc(bfhi(gb.z))); v1[2] *= __builtin_amdgcn_rcpf(1.0f + emc(bflo(gb.w))); v1[3] *= __builtin_amdgcn_rcpf(1.0f + emc(bfhi(gb.w)));
                        *(u32x4*)(O + (size_t)row * 1024 + col0 + bj * HALF) = pack8(v0, v1);
                    }
                }
        }
    }
};
template <int XIN, int XOUT> struct EpiResid {
    static constexpr bool PERM = true, AFTER_DRAIN = false, CARRY = false;
    const float* xin; float* xout; bf16_t* xb; float* sq;
    __device__ __forceinline__ void operator()(const f32x4 (&acc)[2][2][4][2], const Unit& u, int wr, int wc, int fr, int fq) const {
        const int row0 = u.pm * BM + wr * 64 + fr, col0 = u.pn * BM + wc * 32 + 8 * fq;
#pragma unroll
        for (int ai = 0; ai < 2; ++ai)
#pragma unroll
            for (int m = 0; m < 4; ++m) {
                const int row = row0 + ai * HALF + m * 16;
                float s = 0.f;
#pragma unroll
                for (int bj = 0; bj < 2; ++bj) {
                    const size_t off = (size_t)row * 1024 + col0 + bj * HALF;
                    f32x4 a0, a1;
                    if (XIN == 0) { a0 = *(const f32x4*)(xin + off); a1 = *(const f32x4*)(xin + off + 4); }
                    else { const u32x4 xv = *(const u32x4*)(xb + off); a0 = (f32x4){bflo(xv.x), bfhi(xv.x), bflo(xv.y), bfhi(xv.y)}; a1 = (f32x4){bflo(xv.z), bfhi(xv.z), bflo(xv.w), bfhi(xv.w)}; }
                    const f32x4 v0 = acc[ai][bj][m][0] + a0, v1 = acc[ai][bj][m][1] + a1;
                    s += (v0[0] * v0[0] + v0[1] * v0[1]) + (v0[2] * v0[2] + v0[3] * v0[3]) + (v1[0] * v1[0] + v1[1] * v1[1]) + (v1[2] * v1[2] + v1[3] * v1[3]);
                    if (XOUT == 2) { *(f32x4*)(xout + off) = v0; *(f32x4*)(xout + off + 4) = v1; }
                    else *(u32x4*)(xb + off) = pack8(v0, v1);
                }
                s += __shfl_xor(s, 16); s += __shfl_xor(s, 32);
                if (fq == 0) sq[(size_t)row * 16 + u.pn * 4 + wc] = s;
            }
    }
};

__device__ __forceinline__ float dpp_ror1(float x) { return __builtin_bit_cast(float, __builtin_amdgcn_update_dpp(0, __builtin_bit_cast(int, x), 0x121, 0xF, 0xF, false)); }
__device__ __forceinline__ float dpp_rol1(float x) { return __builtin_bit_cast(float, __builtin_amdgcn_update_dpp(0, __builtin_bit_cast(int, x), 0x12F, 0xF, 0xF, false)); }
__device__ __forceinline__ float gelu_t(float x) { const float z = 0.7978845608028654f * (x + 0.044715f * x * x * x); return x * __builtin_amdgcn_rcpf(1.0f + __builtin_amdgcn_exp2f(-2.8853900817779268f * z)); }
__device__ __forceinline__ void ld8w(const float* p, float (&a)[8]) { const f32x4 t0 = *(const f32x4*)p, t1 = *(const f32x4*)(p + 4); a[0] = t0[0]; a[1] = t0[1]; a[2] = t0[2]; a[3] = t0[3]; a[4] = t1[0]; a[5] = t1[1]; a[6] = t1[2]; a[7] = t1[3]; }
typedef unsigned u32x2 __attribute__((ext_vector_type(2)));
__device__ __forceinline__ f32x4 dpp_ror1v(f32x4 x) { f32x4 r; r[0] = dpp_ror1(x[0]); r[1] = dpp_ror1(x[1]); r[2] = dpp_ror1(x[2]); r[3] = dpp_ror1(x[3]); return r; }
__device__ __forceinline__ f32x4 dpp_rol1v(f32x4 x) { f32x4 r; r[0] = dpp_rol1(x[0]); r[1] = dpp_rol1(x[1]); r[2] = dpp_rol1(x[2]); r[3] = dpp_rol1(x[3]); return r; }
__device__ __forceinline__ u32x2 pack4(const f32x4 a) { u32x2 w; w.x = cvt_pk_bf16(a[0], a[1]); w.y = cvt_pk_bf16(a[2], a[3]); return w; }
struct EpiConv {
    static constexpr bool PERM = true, AFTER_DRAIN = false, CARRY = false; static constexpr int MROWS = 16384;
    bf16_t* HG; bf16_t* EDGE; const float* xsq; const float* cw; const float* cb;
    __device__ __forceinline__ void operator()(f32x4 (&acc)[2][2][4][2], const Unit& u, int wr, int wc, int fr, int fq) const {
        const int cola = u.pn * 128 + wc * 32 + 8 * fq;
        bf16_t* const TRASH = EDGE + (size_t)(MROWS / 64) * 4 * 5632 + ((size_t)blockIdx.x * 512 + threadIdx.x) * 8;
#pragma unroll
        for (int ai = 0; ai < 2; ++ai) {
            int rowb = u.pm * BM + ai * HALF + wr * 64;
            asm volatile("" : "+s"(rowb));
            float rs[4];
#pragma unroll
            for (int m = 0; m < 4; ++m) rs[m] = rstd_from16(xsq + (size_t)(rowb + m * 16 + fr) * 16);
#pragma unroll
            for (int hf = 1; hf >= 0; --hf)
#pragma unroll
                for (int n = 0; n < 2; ++n) {
                    int col = hf * 2816 + cola + 4 * n;
                    asm volatile("" : "+v"(col));
                    const f32x4 w0 = *(const f32x4*)(cw + col), w1 = *(const f32x4*)(cw + 5632 + col), w2 = *(const f32x4*)(cw + 2 * 5632 + col), bs = *(const f32x4*)(cb + col);
#pragma unroll
                    for (int m = 0; m < 4; ++m) acc[ai][hf][m][n] = acc[ai][hf][m][n] * rs[m];
                    { bf16_t* e0 = (fr < 2) ? EDGE + ((size_t)(rowb >> 6) * 4 + fr) * 5632 + col : TRASH;
                      bf16_t* e3 = (fr >= 14) ? EDGE + ((size_t)(rowb >> 6) * 4 + (fr - 12)) * 5632 + col : TRASH;
                      *(u32x2*)e0 = pack4(acc[ai][hf][0][n]); *(u32x2*)e3 = pack4(acc[ai][hf][3][n]); }
                    f32x4 rprev = {0.f, 0.f, 0.f, 0.f}, lm = dpp_rol1v(acc[ai][hf][0][n]);
#pragma unroll
                    for (int m = 0; m < 4; ++m) {
                        const f32x4 x = acc[ai][hf][m][n];
                        const f32x4 rm = dpp_ror1v(x);
                        f32x4 ln = {0.f, 0.f, 0.f, 0.f}; if (m < 3) ln = dpp_rol1v(acc[ai][hf][m < 3 ? m + 1 : 3][n]);
                        const f32x4 pv = (fr == 0) ? rprev : rm, nx = (fr == 15) ? ln : lm;
                        acc[ai][hf][m][n] = pv * w0 + x * w1 + nx * w2 + bs;
                        rprev = rm; lm = ln;
                    }
                    asm volatile("" ::: "memory"); __builtin_amdgcn_sched_barrier(0);
                }
#pragma unroll
            for (int m = 0; m < 4; ++m) {
                const bool skip = (m == 0 && fr == 0) || (m == 3 && fr == 15);
                int ro = (rowb + m * 16 + fr) * 2816 + cola;
                asm volatile("" : "+v"(ro));
#pragma unroll
                for (int n = 0; n < 2; ++n) {
                    f32x4 o;
#pragma unroll
                    for (int i = 0; i < 4; ++i) o[i] = gelu_t(acc[ai][0][m][n][i]) * acc[ai][1][m][n][i];
                    *(u32x2*)(skip ? TRASH : HG + (size_t)ro + 4 * n) = pack4(o);
                }
                asm volatile("" ::: "memory"); __builtin_amdgcn_sched_barrier(0);
            }
        }
    }
};

template <class Epi, class Sched, bool ALIGN_EPI = false, bool SP2 = false>
__device__ __forceinline__ void gemm_phase(PG8_LAS unsigned char* lds, const Gemm g, const Sched& S, const Epi& E) {
    const int tid = opaque_tid(), wid = __builtin_amdgcn_readfirstlane(tid >> 6), lane = tid & 63, wr = wid >> 2, wc = wid & 3, fr = lane & 15, fq = lane >> 4;
    const int K = g.K, nt = K / BK;
    unsigned voffA[2], voffB[2];
#pragma unroll
    for (int i = 0; i < 2; ++i) { int R, C; stage_rc(tid * 16 + i * 8192, R, C); const int Rb = Epi::PERM ? ((R & ~31) + perm32(R & 31)) : R;
        voffA[i] = (unsigned)(R * g.lda + C) * 2u; voffB[i] = (unsigned)(Rb * K + C) * 2u; }
    const size_t kstep = (size_t)(BK * 2);
    const size_t hstepA = (size_t)HALF * g.lda * 2, hstepB = (size_t)HALF * K * 2;
    const size_t tstepA = 2 * hstepA, tstepB = 2 * hstepB;
    const unsigned ldsw = (unsigned)wid * 1024u;
    const int aoff = lds_byte(wr * 64 + fr, fq * 8), boff = lds_byte(wc * 32 + fr, fq * 8);
#define PG8_SA(b, h) (((b) * 2 + (h)) * HTB)
#define PG8_SB(b, h) ((4 + (b) * 2 + (h)) * HTB)
#define PG8_STAGE(bufoff, gbase, voff) do { _Pragma("unroll") for (int _i = 0; _i < 2; ++_i) \
        __builtin_amdgcn_global_load_lds((const unsigned*)((const char*)(gbase) + (voff)[_i]), (PG8_LAS unsigned*)(lds + (bufoff) + ldsw + _i * 8192), 16, 0, 0); } while (0)
#define PG8_LDA(dst, b, h) do { _Pragma("unroll") for (int m = 0; m < 4; ++m) _Pragma("unroll") for (int k = 0; k < 2; ++k) dst[m][k] = *(const PG8_LAS bf16x8*)(lds + PG8_SA(b, h) + aoff + m * 2048 + k * 1024); } while (0)
#define PG8_LDB(dst, b, h) do { _Pragma("unroll") for (int n = 0; n < 2; ++n) _Pragma("unroll") for (int k = 0; k < 2; ++k) dst[n][k] = *(const PG8_LAS bf16x8*)(lds + PG8_SB(b, h) + boff + n * 2048 + k * 1024); } while (0)
#define PG8_MMA(ai, bj, At, Bt) do { __builtin_amdgcn_s_setprio(1); _Pragma("unroll") for (int m = 0; m < 4; ++m) _Pragma("unroll") for (int n = 0; n < 2; ++n) _Pragma("unroll") for (int k = 0; k < 2; ++k) \
        acc[ai][bj][m][n] = __builtin_amdgcn_mfma_f32_16x16x32_bf16(Bt[n][k], At[m][k], acc[ai][bj][m][n], 0, 0, 0); __builtin_amdgcn_s_setprio(0); } while (0)
#define PG8_WAIT_V(n) asm volatile("s_waitcnt vmcnt(" #n ")" ::: "memory")
#define PG8_WAIT_L(n) asm volatile("s_waitcnt lgkmcnt(" #n ")" ::: "memory")
#define PG8_BAR __builtin_amdgcn_s_barrier()
#define PG8_SCHED __builtin_amdgcn_sched_barrier(0)
    Unit cur, nxt; int ui = 0;
    if (!S.next(0, cur)) return;
    f32x4 acc[2][2][4][2];
#pragma unroll
    for (int a = 0; a < 2; ++a)
#pragma unroll
        for (int b = 0; b < 2; ++b)
#pragma unroll
            for (int m = 0; m < 4; ++m)
#pragma unroll
                for (int n = 0; n < 2; ++n) acc[a][b][m][n] = (f32x4){0.f, 0.f, 0.f, 0.f};
    bf16x8 At[4][2], B0[2][2], B1[2][2];
    const char* cA = (const char*)g.A + (size_t)cur.pm * tstepA + (size_t)cur.w * g.a2; const char* cB = (const char*)g.Bt + (size_t)cur.pn * tstepB + (size_t)cur.w * g.b2;
    S.a_ready(cur);
    if constexpr (SP2) {
        PG8_STAGE(PG8_SB(0, 0), cB, voffB); PG8_STAGE(PG8_SB(0, 1), cB + hstepB, voffB); PG8_STAGE(PG8_SA(0, 0), cA, voffA); PG8_STAGE(PG8_SA(0, 1), cA + hstepA, voffA);
        if (wr == 1) PG8_BAR;
        PG8_WAIT_V(2); PG8_BAR;
        PG8_STAGE(PG8_SB(1, 0), cB + kstep, voffB); PG8_STAGE(PG8_SA(1, 0), cA + kstep, voffA); PG8_STAGE(PG8_SB(1, 1), cB + hstepB + kstep, voffB);
        PG8_WAIT_V(6); PG8_BAR;
    } else {
        PG8_STAGE(PG8_SB(0, 0), cB, voffB); PG8_STAGE(PG8_SA(0, 0), cA, voffA); PG8_STAGE(PG8_SB(0, 1), cB + hstepB, voffB); PG8_STAGE(PG8_SA(0, 1), cA + hstepA, voffA);
        if (wr == 1) PG8_BAR;
        PG8_WAIT_V(4); PG8_BAR;
        PG8_STAGE(PG8_SB(1, 0), cB + kstep, voffB); PG8_STAGE(PG8_SA(1, 0), cA + kstep, voffA); PG8_STAGE(PG8_SB(1, 1), cB + hstepB + kstep, voffB);
        PG8_WAIT_V(6); PG8_BAR;
    }
    for (;;) {
        const bool has_next = S.next(ui + 1, nxt);
        const char* nA = has_next ? (const char*)g.A + (size_t)nxt.pm * tstepA + (size_t)nxt.w * g.a2 : cA; const char* nB = has_next ? (const char*)g.Bt + (size_t)nxt.pn * tstepB + (size_t)nxt.w * g.b2 : cB;
        for (int t = 0; t < nt; t += 2) {
            const bool last = (t == nt - 2);
            const char* a1 = cA + (size_t)(t + 1) * kstep;
            const char* a2 = last ? nA : cA + (size_t)(t + 2) * kstep; const char* b2 = last ? nB : cB + (size_t)(t + 2) * kstep;
            const char* a3 = a2 + kstep; const char* b3 = b2 + kstep;
            if (last && has_next) S.a_ready(nxt);
            if constexpr (SP2) {
            PG8_LDB(B0, 0, 0); PG8_LDB(B1, 0, 1); PG8_SCHED; PG8_LDA(At, 0, 0); PG8_STAGE(PG8_SA(1, 1), a1 + hstepA, voffA);
            PG8_WAIT_V(8); PG8_WAIT_L(0); PG8_BAR; PG8_MMA(0, 0, At, B0); PG8_MMA(0, 1, At, B1); PG8_BAR; PG8_SCHED;
            PG8_LDA(At, 0, 1); PG8_STAGE(PG8_SB(0, 0), b2, voffB); PG8_STAGE(PG8_SB(0, 1), b2 + hstepB, voffB); PG8_STAGE(PG8_SA(0, 0), a2, voffA);
            PG8_WAIT_V(8); PG8_WAIT_L(0); PG8_BAR; PG8_MMA(1, 0, At, B0); PG8_MMA(1, 1, At, B1); PG8_BAR; PG8_SCHED;
            PG8_LDB(B0, 1, 0); PG8_LDB(B1, 1, 1); PG8_SCHED; PG8_LDA(At, 1, 0); PG8_STAGE(PG8_SA(0, 1), a2 + hstepA, voffA);
            PG8_WAIT_V(8); PG8_WAIT_L(0); PG8_BAR; PG8_MMA(0, 0, At, B0); PG8_MMA(0, 1, At, B1); PG8_BAR; PG8_SCHED;
            PG8_LDA(At, 1, 1); PG8_STAGE(PG8_SB(1, 0), b3, voffB); PG8_STAGE(PG8_SB(1, 1), b3 + hstepB, voffB); PG8_STAGE(PG8_SA(1, 0), a3, voffA);
            PG8_WAIT_V(8); PG8_WAIT_L(0); PG8_BAR; PG8_MMA(1, 0, At, B0); PG8_MMA(1, 1, At, B1); PG8_BAR; PG8_SCHED;
            } else {
            PG8_LDB(B0, 0, 0); PG8_SCHED; PG8_LDA(At, 0, 0); PG8_STAGE(PG8_SA(1, 1), a1 + hstepA, voffA);
            PG8_WAIT_L(8); PG8_BAR; PG8_WAIT_L(0); PG8_MMA(0, 0, At, B0); PG8_BAR; PG8_SCHED;
            PG8_LDB(B1, 0, 1); PG8_STAGE(PG8_SB(0, 0), b2, voffB);
            PG8_BAR; PG8_WAIT_L(0); PG8_MMA(0, 1, At, B1); PG8_BAR;
            PG8_LDA(At, 0, 1); PG8_STAGE(PG8_SA(0, 0), a2, voffA);
            PG8_BAR; PG8_WAIT_L(0); PG8_MMA(1, 0, At, B0); PG8_BAR; PG8_SCHED;
            PG8_STAGE(PG8_SB(0, 1), b2 + hstepB, voffB);
            PG8_WAIT_V(6); PG8_BAR; PG8_MMA(1, 1, At, B1); PG8_BAR;
            PG8_LDB(B0, 1, 0); PG8_SCHED; PG8_LDA(At, 1, 0); PG8_STAGE(PG8_SA(0, 1), a2 + hstepA, voffA);
            PG8_WAIT_L(8); PG8_BAR; PG8_WAIT_L(0); PG8_MMA(0, 0, At, B0); PG8_BAR; PG8_SCHED;
            PG8_LDB(B1, 1, 1); PG8_STAGE(PG8_SB(1, 0), b3, voffB);
            PG8_BAR; PG8_WAIT_L(0); PG8_MMA(0, 1, At, B1); PG8_BAR;
            PG8_LDA(At, 1, 1); PG8_STAGE(PG8_SA(1, 0), a3, voffA);
            PG8_BAR; PG8_WAIT_L(0); PG8_MMA(1, 0, At, B0); PG8_BAR; PG8_SCHED;
            PG8_STAGE(PG8_SB(1, 1), b3 + hstepB, voffB);
            PG8_WAIT_V(6); PG8_BAR; PG8_MMA(1, 1, At, B1); PG8_BAR;
            }
        }
        if constexpr (ALIGN_EPI) { if (wr == 0) PG8_BAR; }
        if constexpr (!Epi::AFTER_DRAIN) { E(acc, cur, wr, wc, fr, fq); S.done(cur); }
        if (!has_next) break;
        if (!(Epi::CARRY && nxt.w == 1)) {
#pragma unroll
        for (int a = 0; a < 2; ++a)
#pragma unroll
            for (int b = 0; b < 2; ++b)
#pragma unroll
                for (int m = 0; m < 4; ++m)
#pragma unroll
                    for (int n = 0; n < 2; ++n) acc[a][b][m][n] = (f32x4){0.f, 0.f, 0.f, 0.f};
        }
        cur = nxt; cA = nA; cB = nB; ++ui;
        if constexpr (ALIGN_EPI) { if (wr == 1) PG8_BAR; }
    }
    PG8_WAIT_V(0);
    if constexpr (!ALIGN_EPI) { if (wr == 0) PG8_BAR; }
    PG8_BAR;
    if constexpr (Epi::AFTER_DRAIN) { E.fused(acc, cur, wr, wc, fr, fq, lds, wid, lane); S.done(cur); }
#undef PG8_SA
#undef PG8_SB
#undef PG8_STAGE
#undef PG8_LDA
#undef PG8_LDB
#undef PG8_MMA
#undef PG8_WAIT_V
#undef PG8_WAIT_L
#undef PG8_BAR
#undef PG8_SCHED
}
}

#define LAS __attribute__((address_space(3)))
typedef unsigned short bf16;
typedef float f32x4 __attribute__((ext_vector_type(4)));
typedef float f32x16 __attribute__((ext_vector_type(16)));
typedef short bf16x8 __attribute__((ext_vector_type(8)));
typedef short s16x4 __attribute__((ext_vector_type(4)));
typedef unsigned u32x4 __attribute__((ext_vector_type(4)));
typedef unsigned u32x2 __attribute__((ext_vector_type(2)));

__device__ __forceinline__ float wave_sum(float v) {
#pragma unroll
    for (int o = 1; o < 64; o <<= 1) v += __shfl_xor(v, o);
    return v;
}
__device__ __forceinline__ unsigned f2bf(float f) { unsigned u = __builtin_bit_cast(unsigned, f); return (u + 0x7fffu + ((u >> 16) & 1u)) >> 16; }
__device__ __forceinline__ unsigned pk2(float lo, float hi) { return f2bf(lo) | (f2bf(hi) << 16); }
__device__ __forceinline__ unsigned cvtpk(float lo, float hi) { return pg8::cvt_pk_bf16(lo, hi); }
__device__ __forceinline__ int crow(int r, int hi) { return (r & 3) + 8 * (r >> 2) + 4 * hi; }
__device__ __forceinline__ float ex2(float x) { return __builtin_amdgcn_exp2f(x); }
__device__ __forceinline__ s16x4 trrd(const LAS unsigned char* p) { return __builtin_bit_cast(s16x4, __builtin_amdgcn_ds_read_tr16_b64_v4i16((LAS s16x4*)p)); }
#define XHALF(v, OP) ({ auto rr_ = __builtin_amdgcn_permlane32_swap(__float_as_uint(v), __float_as_uint(v), false, false); OP(__uint_as_float(rr_[0]), __uint_as_float(rr_[1])); })
__device__ __forceinline__ float fmax2(float a, float b) { return __builtin_fmaxf(a, b); }
__device__ __forceinline__ float fadd2(float a, float b) { return a + b; }

constexpr int DM = 1024, SEQ = 2048, DEPTH = 2, INC = 7168, DFF = 2816, DFF2 = 5632;
constexpr int MG = 16384, NGROUP = 3, MT = 49152;
constexpr int C_U = 0, C_VA = 1024, C_Q = 2048, C_K = 3072, C_VB = 4096, C_GA = 5120, C_GB = 6144;
constexpr float LOG2E = 1.4426950408889634f;

namespace att {
constexpr int KP = 272, VP = 320;
constexpr int L_K = 0, L_V = 2 * 64 * KP, L_B = L_V + 2 * 64 * VP, L_Q = L_B + 16384, L_WS = L_Q + 4 * 32 * KP, L_END = L_WS + 8 * 256;
constexpr int L_X = 0;
static_assert(4 * 64 * 64 * 4 <= L_B, "exchange buffer fits the rings");
constexpr float THR = 8.0f;
#define MFMA32(a, b, c) __builtin_amdgcn_mfma_f32_32x32x16_bf16((a), (b), (c), 0, 0, 0)
#define FMAX(a, b) __builtin_elementwise_maximum((a), (b))

#define T_TILE() do { f32x16 s0, s1; bf16x8 pw0, pw1, pw2, pw3; \
    if (coff != cprev) { cprev = coff; _Pragma("unroll") for (int r = 0; r < 16; ++r) negm[r] = coff - mref; }     \
    _Pragma("unroll") for (int d0_ = 0; d0_ < 4; ++d0_) { \
        const bf16x8 k0_ = *(const LAS bf16x8*)(kb + d0_ * 32); \
        const bf16x8 k1_ = *(const LAS bf16x8*)(kb + 32 * KP + d0_ * 32); \
        if (d0_ == 0) { s0 = MFMA32(k0_, qf[0], negm); s1 = MFMA32(k1_, qf[0], negm); } \
        else { s0 = MFMA32(k0_, qf[d0_], s0); s1 = MFMA32(k1_, qf[d0_], s1); } } \
    if (near) { _Pragma("unroll") for (int r = 0; r < 16; ++r) { s0[r] += bp[(r & 3) + 8 * (r >> 2)]; s1[r] += bp[32 + (r & 3) + 8 * (r >> 2)]; } } \
    float mx = FMAX(s0[0], s1[0]); \
    _Pragma("unroll") for (int r = 1; r < 16; ++r) mx = FMAX(mx, FMAX(s0[r], s1[r])); \
    mx = XHALF(mx, fmax2); \
    if (first || __any(mx > THR)) { \
        const float dl = first ? mx : FMAX(mx, 0.f), alpha = first ? 1.0f : ex2(-dl); mref += dl;     \
        _Pragma("unroll") for (int r = 0; r < 16; ++r) { s0[r] -= dl; s1[r] -= dl; negm[r] -= dl; } \
        if (hi == 0) wsf[r32] = alpha; \
        asm volatile("s_waitcnt lgkmcnt(0)" ::: "memory"); \
        _Pragma("unroll") for (int r = 0; r < 16; ++r) { const float al = wsf[crow(r, hi)]; osum[r] *= al; \
            _Pragma("unroll") for (int db = 0; db < 4; ++db) o[db][r] *= al; } \
        asm volatile("s_waitcnt lgkmcnt(0)" ::: "memory"); } \
    _Pragma("unroll") for (int r = 0; r < 16; ++r) { s0[r] = ex2(s0[r]); s1[r] = ex2(s1[r]); } \
    { u32x4 w; \
      w.x = cvtpk(s0[0], s0[1]); w.y = cvtpk(s0[2], s0[3]); w.z = cvtpk(s0[4], s0[5]); w.w = cvtpk(s0[6], s0[7]); pw0 = __builtin_bit_cast(bf16x8, w); \
      w.x = cvtpk(s0[8], s0[9]); w.y = cvtpk(s0[10], s0[11]); w.z = cvtpk(s0[12], s0[13]); w.w = cvtpk(s0[14], s0[15]); pw1 = __builtin_bit_cast(bf16x8, w); \
      w.x = cvtpk(s1[0], s1[1]); w.y = cvtpk(s1[2], s1[3]); w.z = cvtpk(s1[4], s1[5]); w.w = cvtpk(s1[6], s1[7]); pw2 = __builtin_bit_cast(bf16x8, w); \
      w.x = cvtpk(s1[8], s1[9]); w.y = cvtpk(s1[10], s1[11]); w.z = cvtpk(s1[12], s1[13]); w.w = cvtpk(s1[14], s1[15]); pw3 = __builtin_bit_cast(bf16x8, w); } \
    osum = MFMA32(pw0, ones, osum); osum = MFMA32(pw1, ones, osum); osum = MFMA32(pw2, ones, osum); osum = MFMA32(pw3, ones, osum);     \
    _Pragma("unroll") for (int db = 0; db < 4; ++db) { \
        const s16x4 a0 = trrd(vb + 0 * VP + db * 64), a1 = trrd(vb + 8 * VP + db * 64), a2 = trrd(vb + 16 * VP + db * 64), a3 = trrd(vb + 24 * VP + db * 64); \
        const s16x4 a4 = trrd(vb + 32 * VP + db * 64), a5 = trrd(vb + 40 * VP + db * 64), a6 = trrd(vb + 48 * VP + db * 64), a7 = trrd(vb + 56 * VP + db * 64); \
        o[db] = MFMA32(pw0, ((bf16x8){a0[0], a0[1], a0[2], a0[3], a1[0], a1[1], a1[2], a1[3]}), o[db]); \
        o[db] = MFMA32(pw1, ((bf16x8){a2[0], a2[1], a2[2], a2[3], a3[0], a3[1], a3[2], a3[3]}), o[db]); \
        o[db] = MFMA32(pw2, ((bf16x8){a4[0], a4[1], a4[2], a4[3], a5[0], a5[1], a5[2], a5[3]}), o[db]); \
        o[db] = MFMA32(pw3, ((bf16x8){a6[0], a6[1], a6[2], a6[3], a7[0], a7[1], a7[2], a7[3]}), o[db]); } } while (0)

#define TILE_CLASS(t) (((t) * 64 - (qw0 + 31) >= 128) ? 1 : ((qw0 - ((t) * 64 + 63) >= 128) ? -1 : 0))

__device__ __forceinline__ void attn_unit(LAS unsigned char* lds, bf16* proj, int b, int h, int qb, const float* tbh, const float* lq, int layer, const float* subg) {
    const int tid = opaque_tid(), lane = tid & 63, r32 = lane & 31, hi = lane >> 5;
    const int wid = __builtin_amdgcn_readfirstlane(tid >> 6), qg = wid & 3, mp = wid >> 2;
    LAS float* bl = (LAS float*)(lds + L_B);
#pragma unroll
    for (int i = 0; i < 2; ++i) ((LAS f32x4*)bl)[tid + 512 * i] = ((const f32x4*)tbh)[tid + 512 * i];
    const float cpos = __uint_as_float(__builtin_amdgcn_readfirstlane(__float_as_uint(tbh[4095]))), cneg = __uint_as_float(__builtin_amdgcn_readfirstlane(__float_as_uint(tbh[1])));
    const size_t rowbase = (size_t)b * SEQ;
    const int qw0 = qb * 128 + qg * 32, qpos = qw0 + r32;
    const LAS float* blq = bl + (2048 - qpos + 4 * hi);
    LAS float* wsf = (LAS float*)(lds + L_WS + wid * 256);
    bf16x8 qf[4];
    { const bf16* Qg = proj + (rowbase + qpos) * INC + C_Q + h * 128 + mp * 64 + hi * 8;
#pragma unroll
      for (int d0 = 0; d0 < 4; ++d0) qf[d0] = *(const bf16x8*)(Qg + d0 * 16); }
    const int srow = tid >> 4, scc = tid & 15;
    const bf16* kg0 = proj + (rowbase + srow) * INC + C_K + h * 128 + scc * 8;
    const bf16* vg0 = proj + (rowbase + srow) * INC + C_VB + h * 128 + scc * 8;
    LAS unsigned char* kdst = lds + L_K + srow * KP + scc * 16;
    LAS unsigned char* vdst = lds + L_V + srow * VP + scc * 16;
    const LAS unsigned char* kb0 = lds + L_K + r32 * KP + mp * 128 + hi * 16;
    const LAS unsigned char* vb0 = lds + L_V + (4 * hi + ((lane >> 2) & 3)) * VP + (((lane >> 4) & 1) * 16 + (lane & 3) * 4) * 2;
    u32x4 kr[2], vr[2];
#define LOADK(t) do { _Pragma("unroll") for (int i = 0; i < 2; ++i) kr[i] = *(const u32x4*)(kg0 + (size_t)((t) * 64 + i * 32) * INC); } while (0)
#define LOADV(t) do { _Pragma("unroll") for (int i = 0; i < 2; ++i) vr[i] = *(const u32x4*)(vg0 + (size_t)((t) * 64 + i * 32) * INC); } while (0)
#define STOREK(buf) do { _Pragma("unroll") for (int i = 0; i < 2; ++i) *(LAS u32x4*)(kdst + (buf) * 64 * KP + i * 32 * KP) = kr[i]; } while (0)
#define STOREV(buf) do { _Pragma("unroll") for (int i = 0; i < 2; ++i) *(LAS u32x4*)(vdst + (buf) * 64 * VP + i * 32 * VP) = vr[i]; } while (0)
    float mref = 0.f, cprev = 0.f;
    f32x16 negm;
#pragma unroll
    for (int r = 0; r < 16; ++r) negm[r] = 0.f;
    f32x16 o[4], osum;
    const bf16x8 ones = {0x3F80, 0x3F80, 0x3F80, 0x3F80, 0x3F80, 0x3F80, 0x3F80, 0x3F80};
#pragma unroll
    for (int r = 0; r < 16; ++r) osum[r] = 0.f;
#pragma unroll
    for (int i = 0; i < 4; ++i)
#pragma unroll
        for (int r = 0; r < 16; ++r) o[i][r] = 0.f;
    LOADK(0); LOADV(0); STOREK(0); STOREV(0); LOADK(1); LOADV(1);
    __syncthreads();
    for (int t = 0; t < 32; ++t) {
        const int buf = t & 1;
        if (t + 1 < 32) { STOREK(buf ^ 1); STOREV(buf ^ 1); }
        if (t + 2 < 32) { LOADK(t + 2); LOADV(t + 2); }
        const LAS unsigned char* kb = kb0 + buf * 64 * KP;
        const LAS unsigned char* vb = vb0 + buf * 64 * VP;
        const int tc = TILE_CLASS(t);
        const bool near = (tc == 0), first = (t == 0); const LAS float* bp = blq + t * 64; const float coff = near ? 0.f : (tc > 0 ? cpos : cneg);
        T_TILE();
        __syncthreads();
    }
    float pa = lq[lane] * lq[64 + lane], pb = lq[128 + lane] * lq[192 + lane];
    pa = wave_sum(pa); pb = wave_sum(pb);
    const float lam = __expf(pa) - __expf(pb) + __uint_as_float(layer ? 0x3EB60549u : 0x3E4CCCCDu);
    { const float num = (mp == 0) ? 1.0f : lam;
#pragma unroll
      for (int r = 0; r < 16; ++r) { const float al = num * __builtin_amdgcn_rcpf(osum[r]);
#pragma unroll
          for (int db = 0; db < 4; ++db) o[db][r] *= al; } }
    LAS float* xb = (LAS float*)(lds + L_X) + qg * 4096 + lane;
    if (mp == 1) {
#pragma unroll
        for (int db = 0; db < 4; ++db)
#pragma unroll
            for (int r = 0; r < 16; ++r) xb[(db * 16 + r) * 64] = o[db][r];
    }
    __syncthreads();
    if (mp == 0) {
        float gsc[4];
        const float oml = __uint_as_float(layer ? 0x3F24FD5Cu : 0x3F4CCCCDu);
#pragma unroll
        for (int db = 0; db < 4; ++db) gsc[db] = subg[db * 32 + r32] * oml;
        bf16* Op = proj + (rowbase + qw0) * INC + C_Q + h * 128 + r32;
#pragma unroll
        for (int r = 0; r < 16; ++r) {
            float ov[4];
#pragma unroll
            for (int db = 0; db < 4; ++db) ov[db] = o[db][r] - xb[(db * 16 + r) * 64];
            float ss = (ov[0] * ov[0] + ov[1] * ov[1]) + (ov[2] * ov[2] + ov[3] * ov[3]);
#pragma unroll
            for (int of = 1; of < 32; of <<= 1) ss += __shfl_xor(ss, of);
            const float rs = rsqrtf(ss * (1.0f / 128.0f) + 1e-6f);
            bf16* op = Op + (size_t)crow(r, hi) * INC;
#pragma unroll
            for (int db = 0; db < 4; ++db) op[db * 32] = (bf16)f2bf(ov[db] * rs * gsc[db]);
        }
    }
    asm volatile("s_waitcnt lgkmcnt(0)" ::: "memory");
#undef LOADK
#undef LOADV
#undef STOREK
#undef STOREV
}
}

namespace sgu {
constexpr int VP = 320, L_R = 128 * VP;
__device__ __forceinline__ void sgu_unit(LAS unsigned char* lds, bf16* proj, int n, int g, const float* W, const float* bvec, const float* gch, const float* vsq) {
    const int tid = opaque_tid(), lane = tid & 63, r32 = lane & 31, hi = lane >> 5;
    const int wid = __builtin_amdgcn_readfirstlane(tid >> 6);
    LAS float* rl = (LAS float*)(lds + L_R);
    const size_t row0 = (size_t)n * 128;
    const int tblk = wid >> 1, cb0 = 2 * (wid & 1);
    u32x4 vt[4];
#pragma unroll
    for (int i = 0; i < 4; ++i) { const int c = tid + 512 * i, row = c >> 4, cc = c & 15; vt[i] = *(const u32x4*)(proj + (row0 + row) * INC + C_VA + g * 128 + cc * 8); }
    float rsv = 0.f; if (tid < 128) rsv = pg8::rstd_from16(vsq + (row0 + tid) * 16);
    const float* Wr = W + (size_t)(tblk * 32 + r32) * 128 + hi * 4;
    f32x4 wv[8][2];
#pragma unroll
    for (int ks = 0; ks < 8; ++ks) { wv[ks][0] = *(const f32x4*)(Wr + ks * 16); wv[ks][1] = *(const f32x4*)(Wr + ks * 16 + 8); }
    float bt[16], gs[2]; bf16 uv[2][16];
#pragma unroll
    for (int r = 0; r < 16; ++r) bt[r] = bvec[tblk * 32 + crow(r, hi)];
    bf16* ubase = proj + row0 * INC + C_U + g * 128 + cb0 * 32 + r32;
#pragma unroll
    for (int c = 0; c < 2; ++c) { gs[c] = gch[(cb0 + c) * 32 + r32];
#pragma unroll
        for (int r = 0; r < 16; ++r) uv[c][r] = ubase[(size_t)(tblk * 32 + crow(r, hi)) * INC + c * 32]; }
#pragma unroll
    for (int i = 0; i < 4; ++i) { const int c = tid + 512 * i, row = c >> 4, cc = c & 15; *(LAS u32x4*)(lds + row * VP + cc * 16) = vt[i]; }
    if (tid < 128) rl[tid] = rsv;
    __syncthreads();
    f32x16 acc[2];
#pragma unroll
    for (int c = 0; c < 2; ++c)
#pragma unroll
        for (int r = 0; r < 16; ++r) acc[c][r] = 0.f;
    const LAS unsigned char* vb = lds + (4 * hi + ((lane >> 2) & 3)) * VP + (((lane >> 4) & 1) * 16 + (lane & 3) * 4) * 2;
#pragma unroll
    for (int ks = 0; ks < 8; ++ks) {
        const f32x4 r0 = *(const LAS f32x4*)(rl + ks * 16 + hi * 4), r1 = *(const LAS f32x4*)(rl + ks * 16 + hi * 4 + 8);
        const f32x4 a0 = wv[ks][0] * r0, a1 = wv[ks][1] * r1;
        const bf16x8 af = __builtin_bit_cast(bf16x8, pg8::pack8(a0, a1));
#pragma unroll
        for (int c = 0; c < 2; ++c) {
            const s16x4 lo = trrd(vb + (16 * ks) * VP + (cb0 + c) * 64), hh = trrd(vb + (16 * ks + 8) * VP + (cb0 + c) * 64);
            const bf16x8 vf = (bf16x8){lo[0], lo[1], lo[2], lo[3], hh[0], hh[1], hh[2], hh[3]};
            acc[c] = MFMA32(af, vf, acc[c]);
        }
    }
#pragma unroll
    for (int c = 0; c < 2; ++c)
#pragma unroll
        for (int r = 0; r < 16; ++r) {
            const float u = __uint_as_float((unsigned)uv[c][r] << 16);
            ubase[(size_t)(tblk * 32 + crow(r, hi)) * INC + c * 32] = (bf16)f2bf(u * (gs[c] * acc[c][r] + bt[r]));
        }
    __syncthreads();
}
__device__ __forceinline__ void sgu_phase(LAS unsigned char* lds, bf16* proj, int vcu, int G, const float* Wl, const float* bl, const float* gl, const float* vsq) {
    const int tid = opaque_tid(), lane = tid & 63, r32 = lane & 31, hi = lane >> 5;
    const int wid = __builtin_amdgcn_readfirstlane(tid >> 6);
    const int nun = (1024 - vcu + G - 1) / G;
    if (nun <= 0) return;
    constexpr int VBUF = 128 * VP;
    LAS float* rl = (LAS float*)(lds + 2 * VBUF);
    const int tblk = wid >> 1, cb0 = 2 * (wid & 1);
    const LAS unsigned char* vb0 = lds + (4 * hi + ((lane >> 2) & 3)) * VP + (((lane >> 4) & 1) * 16 + (lane & 3) * 4) * 2;
    f32x4 wv[8][2]; float bt[16], gs[2]; int gprev = -1;
    u32x4 vtN[4]; float rsN = 0.f; bf16 uC[2][16];
#define SGU_LOAD(id_) do { const int n_ = (id_) >> 3, g_ = (id_) & 7; const size_t row0_ = (size_t)n_ * 128; \
        _Pragma("unroll") for (int i_ = 0; i_ < 4; ++i_) { const int c_ = tid + 512 * i_, row_ = c_ >> 4, cc_ = c_ & 15; vtN[i_] = *(const u32x4*)(proj + (row0_ + row_) * INC + C_VA + g_ * 128 + cc_ * 8); } \
        if (tid < 128) rsN = pg8::rstd_from16(vsq + (row0_ + tid) * 16); } while (0)
#define SGU_STAGE(b_) do { _Pragma("unroll") for (int i_ = 0; i_ < 4; ++i_) { const int c_ = tid + 512 * i_, row_ = c_ >> 4, cc_ = c_ & 15; *(LAS u32x4*)(lds + (b_) * VBUF + row_ * VP + cc_ * 16) = vtN[i_]; } \
        if (tid < 128) rl[(b_) * 128 + tid] = rsN; } while (0)
    SGU_LOAD(vcu);
    SGU_STAGE(0);
    for (int i = 0; i < nun; ++i) {
        const int id = i * G + vcu, n = id >> 3, g = id & 7, b = i & 1;
        if (g != gprev) {
            gprev = g;
            const float* Wr = Wl + (size_t)g * 128 * 128 + (size_t)(tblk * 32 + r32) * 128 + hi * 4;
#pragma unroll
            for (int ks = 0; ks < 8; ++ks) { wv[ks][0] = *(const f32x4*)(Wr + ks * 16); wv[ks][1] = *(const f32x4*)(Wr + ks * 16 + 8); }
#pragma unroll
            for (int r = 0; r < 16; ++r) bt[r] = bl[g * 128 + tblk * 32 + crow(r, hi)];
#pragma unroll
            for (int c = 0; c < 2; ++c) gs[c] = gl[g * 128 + (cb0 + c) * 32 + r32];
        }
        __syncthreads();
        const bool more = (i + 1 < nun);
        if (more) SGU_LOAD(id + G);
        bf16* ubase = proj + (size_t)n * 128 * INC + C_U + g * 128 + (size_t)(tblk * 32) * INC + cb0 * 32;
        const unsigned uoff = (unsigned)(4 * hi) * INC + r32;
#pragma unroll
        for (int c = 0; c < 2; ++c)
#pragma unroll
            for (int r = 0; r < 16; ++r) uC[c][r] = (ubase + (size_t)((r & 3) + 8 * (r >> 2)) * INC + c * 32)[uoff];
        f32x16 acc[2];
#pragma unroll
        for (int c = 0; c < 2; ++c)
#pragma unroll
            for (int r = 0; r < 16; ++r) acc[c][r] = 0.f;
        const LAS unsigned char* vb = vb0 + b * VBUF; const LAS float* rlb = rl + b * 128;
#pragma unroll
        for (int ks = 0; ks < 8; ++ks) {
            const f32x4 r0 = *(const LAS f32x4*)(rlb + ks * 16 + hi * 4), r1 = *(const LAS f32x4*)(rlb + ks * 16 + hi * 4 + 8);
            const f32x4 a0 = wv[ks][0] * r0, a1 = wv[ks][1] * r1;
            const bf16x8 af = __builtin_bit_cast(bf16x8, pg8::pack8(a0, a1));
#pragma unroll
            for (int c = 0; c < 2; ++c) {
                const s16x4 lo = trrd(vb + (16 * ks) * VP + (cb0 + c) * 64), hh = trrd(vb + (16 * ks + 8) * VP + (cb0 + c) * 64);
                const bf16x8 vf = (bf16x8){lo[0], lo[1], lo[2], lo[3], hh[0], hh[1], hh[2], hh[3]};
                acc[c] = MFMA32(af, vf, acc[c]);
            }
        }
#pragma unroll
        for (int c = 0; c < 2; ++c)
#pragma unroll
            for (int r = 0; r < 16; ++r) {
                const float u = __uint_as_float((unsigned)uC[c][r] << 16);
                (ubase + (size_t)((r & 3) + 8 * (r >> 2)) * INC + c * 32)[uoff] = (bf16)f2bf(u * (gs[c] * acc[c][r] + bt[r]));
            }
        if (more) SGU_STAGE(b ^ 1);
    }
    __syncthreads();
#undef SGU_LOAD
#undef SGU_STAGE
}
}

constexpr size_t MiB = 1u << 20;
constexpr size_t WS_BAR = 512 * 1024, BAR_BYTES = 16384;
constexpr size_t WS_TB = 0, WS_VSQ = 1 * MiB, WS_XSQ = 2 * MiB, WS_WIN = 6 * MiB, WS_WBR = 34 * MiB, WS_WOUT = 42 * MiB, WS_WUP = 46 * MiB, WS_WDN = 68 * MiB;
constexpr size_t WS_XB = 80 * MiB, WS_PROJ = 176 * MiB, WS_MRG = 400 * MiB, WS_END = 488 * MiB;
static_assert(WS_WIN + (size_t)DEPTH * INC * DM * 2 <= WS_WBR && WS_WUP + (size_t)DEPTH * DFF2 * DM * 2 <= WS_WDN && WS_WDN + (size_t)DEPTH * DM * DFF * 2 <= WS_XB, "weights map");
static_assert(WS_XB + (size_t)MT * DM * 2 <= WS_PROJ && WS_PROJ + (size_t)MG * INC * 2 <= WS_MRG && WS_MRG + (size_t)MG * DFF * 2 <= WS_END, "activation map");
constexpr int LDS_BYTES = 163840;
static_assert(att::L_END <= LDS_BYTES, "attention LDS map");
constexpr int NWAVES = 8, NTHREADS = 512;
constexpr int NPH = 1 + NGROUP * 12 + 1;
constexpr int LDS_BAR_OFF = LDS_BYTES - 64;

__device__ __forceinline__ void transpose_item(const float* W, const float* gk, int K, int N, bf16* WT, LAS float* scr, int item, int lane, bool perm_up = false) {
    const int nblk = N / 32, kb = item / nblk, nb = item % nblk, k0 = 64 * kb, n0 = 32 * nb;
    const int nd0 = !perm_up ? n0 : (n0 < 2816 ? 256 * (n0 / 128) + n0 % 128 : 256 * ((n0 - 2816) / 128) + 128 + (n0 - 2816) % 128);
#pragma unroll 8
    for (int i = 0; i < 32; ++i) { const int kk = 2 * i + (lane >> 5); const float sc = gk ? gk[k0 + kk] : 1.0f; scr[kk * 33 + (lane & 31)] = W[(size_t)(k0 + kk) * N + n0 + (lane & 31)] * sc; }
    asm volatile("s_waitcnt lgkmcnt(0)" ::: "memory");
    const int c = lane & 7;
#pragma unroll
    for (int j = 0; j < 4; ++j) { const int n = (lane >> 3) + 8 * j; const LAS float* s = scr + (8 * c) * 33 + n;
        u32x4 o; o.x = pk2(s[0 * 33], s[1 * 33]); o.y = pk2(s[2 * 33], s[3 * 33]); o.z = pk2(s[4 * 33], s[5 * 33]); o.w = pk2(s[6 * 33], s[7 * 33]);
        *(u32x4*)(WT + (size_t)(nd0 + n) * K + k0 + 8 * c) = o; }
    asm volatile("s_waitcnt lgkmcnt(0)" ::: "memory");
}
__device__ __forceinline__ int rel_bucket(int rel) {
    const int n = rel < 0 ? -rel : rel;
    const int large = 8 + (n >= 12) + (n >= 16) + (n >= 23) + (n >= 32) + (n >= 46) + (n >= 64) + (n >= 91);
    return (rel > 0 ? 16 : 0) + (n < 8 ? n : large);
}
__device__ __forceinline__ void ld8(const bf16* p, float (&a)[8]) {
    const u32x4 v = *(const u32x4*)p;
    a[0] = pg8::bflo(v.x); a[1] = pg8::bfhi(v.x); a[2] = pg8::bflo(v.y); a[3] = pg8::bfhi(v.y); a[4] = pg8::bflo(v.z); a[5] = pg8::bfhi(v.z); a[6] = pg8::bflo(v.w); a[7] = pg8::bfhi(v.w);
}
__device__ __forceinline__ void ld8f(const float* p, float (&a)[8]) {
    const f32x4 v0 = *(const f32x4*)p, v1 = *(const f32x4*)(p + 4);
    a[0] = v0[0]; a[1] = v0[1]; a[2] = v0[2]; a[3] = v0[3]; a[4] = v1[0]; a[5] = v1[1]; a[6] = v1[2]; a[7] = v1[3];
}
__device__ __forceinline__ float gelu_tanh(float x) {
    const float z = 0.7978845608028654f * (x + 0.044715f * x * x * x);
    return x * __builtin_amdgcn_rcpf(1.0f + __builtin_amdgcn_exp2f(-2.0f * LOG2E * z));
}
__device__ __forceinline__ void conv_gate_phase(const bf16* __restrict__ up, bf16* __restrict__ hg, const float* __restrict__ cw, const float* __restrict__ cbias, int gtid, int gthreads) {
    constexpr int R = 16, NCH = DFF / 8;
    const int nitems = (MG / R) * NCH;
    for (int it = gtid; it < nitems; it += gthreads) {
        const int rb = it / NCH, ch = it - rb * NCH, col = ch * 8, row0 = rb * R, t0 = row0 & (SEQ - 1);
        float wa[3][8], wb[3][8], ba[8], bb[8];
#pragma unroll
        for (int j = 0; j < 3; ++j) { ld8f(cw + (size_t)j * DFF2 + col, wa[j]); ld8f(cw + (size_t)j * DFF2 + DFF + col, wb[j]); }
        ld8f(cbias + col, ba); ld8f(cbias + DFF + col, bb);
        float pa[8], pb[8], ca[8], cb[8];
        const bf16* urow = up + (size_t)row0 * DFF2 + col;
        if (t0 == 0) {
#pragma unroll
            for (int e = 0; e < 8; ++e) { pa[e] = 0.f; pb[e] = 0.f; }
        } else { ld8(urow - DFF2, pa); ld8(urow - DFF2 + DFF, pb); }
        ld8(urow, ca); ld8(urow + DFF, cb);
#pragma unroll 1
        for (int r0 = 0; r0 < R; r0 += 4) {
            u32x4 ra[4], rb[4];
#pragma unroll
            for (int j = 0; j < 4; ++j) {
                if (t0 + r0 + j + 1 == SEQ) { ra[j] = (u32x4){0u, 0u, 0u, 0u}; rb[j] = (u32x4){0u, 0u, 0u, 0u}; }
                else { ra[j] = *(const u32x4*)(urow + (size_t)(r0 + j + 1) * DFF2); rb[j] = *(const u32x4*)(urow + (size_t)(r0 + j + 1) * DFF2 + DFF); }
            }
#pragma unroll
            for (int j = 0; j < 4; ++j) {
                float na[8], nb[8], o[8];
                na[0] = pg8::bflo(ra[j].x); na[1] = pg8::bfhi(ra[j].x); na[2] = pg8::bflo(ra[j].y); na[3] = pg8::bfhi(ra[j].y); na[4] = pg8::bflo(ra[j].z); na[5] = pg8::bfhi(ra[j].z); na[6] = pg8::bflo(ra[j].w); na[7] = pg8::bfhi(ra[j].w);
                nb[0] = pg8::bflo(rb[j].x); nb[1] = pg8::bfhi(rb[j].x); nb[2] = pg8::bflo(rb[j].y); nb[3] = pg8::bfhi(rb[j].y); nb[4] = pg8::bflo(rb[j].z); nb[5] = pg8::bfhi(rb[j].z); nb[6] = pg8::bflo(rb[j].w); nb[7] = pg8::bfhi(rb[j].w);
#pragma unroll
                for (int e = 0; e < 8; ++e) {
                    const float va = pa[e] * wa[0][e] + ca[e] * wa[1][e] + na[e] * wa[2][e] + ba[e];
                    const float vb = pb[e] * wb[0][e] + cb[e] * wb[1][e] + nb[e] * wb[2][e] + bb[e];
                    o[e] = gelu_tanh(va) * vb;
                }
                u32x4 w; w.x = cvtpk(o[0], o[1]); w.y = cvtpk(o[2], o[3]); w.z = cvtpk(o[4], o[5]); w.w = cvtpk(o[6], o[7]);
                *(u32x4*)(hg + (size_t)(row0 + r0 + j) * DFF + col) = w;
#pragma unroll
                for (int e = 0; e < 8; ++e) { pa[e] = ca[e]; pb[e] = cb[e]; ca[e] = na[e]; cb[e] = nb[e]; }
            }
        }
    }
}

#define XB_TMO      128
#define XB_XCNT(j)  (256  + 64 * (j))
#define XB_XSUB(j)  (1280 + 64 * (j))
#define XB_XGEN(j)  (2304 + 64 * (j))
#define XB_TOP      3328
#define XB_TOPGEN   3392
#define XCD_BAR_WORDS 3456
#define XB_SPIN_CAP (1u << 18)

__device__ __forceinline__ unsigned xb_ld(unsigned* p)              { return __hip_atomic_load(p, __ATOMIC_RELAXED, __HIP_MEMORY_SCOPE_AGENT); }
__device__ __forceinline__ unsigned xb_add(unsigned* p, unsigned v) { return __hip_atomic_fetch_add(p, v, __ATOMIC_RELAXED, __HIP_MEMORY_SCOPE_AGENT); }
__device__ __forceinline__ unsigned xb_xcc_id() { return (unsigned)__builtin_amdgcn_s_getreg((3 << 11) | 20) & 0xFu; }
#define XB_SPIN(cond, bar) do { unsigned _sp = 0; while (cond) { __builtin_amdgcn_s_sleep(1); \
    if ((++_sp & 255u) == 0u) { if (xb_ld(&(bar)[XB_TMO])) break; if (_sp > XB_SPIN_CAP) { atomicAdd(&(bar)[XB_TMO], 1u); break; } } } } while (0)

struct XcdBarrier {
    unsigned* bar; unsigned x;
    volatile LAS unsigned* st;
};

__device__ __forceinline__ XcdBarrier xcd_barrier_post(unsigned* bar, volatile LAS unsigned* st) {
    XcdBarrier b; b.bar = bar; b.x = xb_xcc_id(); b.st = st;
    if (threadIdx.x == 0) (void)xb_add(&bar[XB_XCNT(b.x)], 1u);
    return b;
}
__device__ __forceinline__ void xcd_barrier_complete(unsigned* bar, unsigned x, unsigned& nloc, unsigned& nx) {
    const unsigned G = gridDim.x * gridDim.y * gridDim.z;
    unsigned sum, cnt, mine, sp = 0u;
    for (;;) {
        sum = 0u; cnt = 0u; mine = 0u;
#pragma unroll
        for (unsigned j = 0; j < 16; ++j) { const unsigned c = xb_ld(&bar[XB_XCNT(j)]); sum += c; cnt += (c > 0u) ? 1u : 0u; mine = (j == x) ? c : mine; }
        if (sum == G) break;
        __builtin_amdgcn_s_sleep(1);
        if ((++sp & 255u) == 0u) { if (xb_ld(&bar[XB_TMO])) break; if (sp > XB_SPIN_CAP) { atomicAdd(&bar[XB_TMO], 1u); break; } }
    }
    nloc = mine > 0u ? mine : 1u; nx = cnt > 0u ? cnt : 1u;
}

__device__ __forceinline__ void xcd_barrier(const XcdBarrier& b) {
    asm volatile("s_waitcnt vmcnt(0)" ::: "memory");
    __syncthreads();
    if (threadIdx.x == 0) {
        unsigned* bar = b.bar;
        __builtin_amdgcn_s_waitcnt(0);
        unsigned nloc = b.st[0], nx = b.st[1];
        if (nloc == 0u) { xcd_barrier_complete(bar, b.x, nloc, nx); b.st[0] = nloc; b.st[1] = nx; }
        const unsigned old = xb_add(&bar[XB_XSUB(b.x)], 1u);
        const unsigned gen = old / nloc;
        if (old + 1u == (gen + 1u) * nloc) {
            __builtin_amdgcn_fence(__ATOMIC_RELEASE, "agent");
            asm volatile("s_waitcnt vmcnt(0)" ::: "memory");
            const unsigned og = xb_add(&bar[XB_TOP], 1u);
            const unsigned tg = og / nx;
            if (og + 1u == (tg + 1u) * nx) xb_add(&bar[XB_TOPGEN], 1u);
            else XB_SPIN(xb_ld(&bar[XB_TOPGEN]) == tg, bar);
            __builtin_amdgcn_fence(__ATOMIC_ACQUIRE, "agent");
            xb_add(&bar[XB_XGEN(b.x)], 1u);
            asm volatile("s_waitcnt vmcnt(0)" ::: "memory");
        } else {
            XB_SPIN(xb_ld(&bar[XB_XGEN(b.x)]) == gen, bar);
            __builtin_amdgcn_fence(__ATOMIC_ACQUIRE, "agent");
            asm volatile("s_waitcnt vmcnt(0)" ::: "memory");
        }
    }
    __syncthreads();
}

__device__ __forceinline__ void conv_edge_fixup(const bf16* __restrict__ EDGE, bf16* __restrict__ hg, const float* __restrict__ cw, const float* __restrict__ cbias, int pm, int tid) {
    constexpr int NCH = DFF / 8;
    for (int it = tid; it < 8 * NCH; it += NTHREADS) {
        const int rsel = it / NCH, ch = it - rsel * NCH, col = ch * 8, bq = rsel >> 1, hiRow = rsel & 1;
        const int blk = pm * 4 + bq, row = blk * 64 + (hiRow ? 63 : 0), t = row & (SEQ - 1);
        const bf16* pc = EDGE + ((size_t)blk * 4 + (hiRow ? 3 : 0)) * DFF2 + col;
        const bf16* pp = (hiRow ? EDGE + ((size_t)blk * 4 + 2) * DFF2 : EDGE + ((size_t)(blk - 1) * 4 + 3) * DFF2) + col;
        const bf16* pn = (hiRow ? EDGE + ((size_t)(blk + 1) * 4 + 0) * DFF2 : EDGE + ((size_t)blk * 4 + 1) * DFF2) + col;
        const bool zp = (!hiRow && t == 0), zn = (hiRow && t == SEQ - 1);
        float pa[8], pb[8], ca[8], cb[8], na[8], nb[8];
        if (zp) {
#pragma unroll
            for (int e = 0; e < 8; ++e) { pa[e] = 0.f; pb[e] = 0.f; }
        } else { ld8(pp, pa); ld8(pp + DFF, pb); }
        if (zn) {
#pragma unroll
            for (int e = 0; e < 8; ++e) { na[e] = 0.f; nb[e] = 0.f; }
        } else { ld8(pn, na); ld8(pn + DFF, nb); }
        ld8(pc, ca); ld8(pc + DFF, cb);
        float o[8];
#pragma unroll
        for (int hf = 0; hf < 2; ++hf) {
            float w0[8], w1[8], w2[8], bs[8];
            ld8f(cw + hf * DFF + col, w0); ld8f(cw + DFF2 + hf * DFF + col, w1); ld8f(cw + 2 * DFF2 + hf * DFF + col, w2); ld8f(cbias + hf * DFF + col, bs);
#pragma unroll
            for (int e = 0; e < 8; ++e) {
                if (hf == 0) o[e] = gelu_tanh(pa[e] * w0[e] + ca[e] * w1[e] + na[e] * w2[e] + bs[e]);
                else o[e] *= pb[e] * w0[e] + cb[e] * w1[e] + nb[e] * w2[e] + bs[e];
            }
        }
        u32x4 w; w.x = cvtpk(o[0], o[1]); w.y = cvtpk(o[2], o[3]); w.z = cvtpk(o[4], o[5]); w.w = cvtpk(o[6], o[7]);
        *(u32x4*)(hg + (size_t)row * DFF + col) = w;
    }
}

__device__ __forceinline__ void final_norm_group(float* xres, const float* xsq_g, const float* gfin, int gw, int NGW, int lane) {
    for (int m = gw; m < MG; m += NGW) {
        const float rs = pg8::rstd_from16(xsq_g + (size_t)m * 16);
        f32x4* xr = (f32x4*)(xres + (size_t)m * DM) + lane; const f32x4* gr = (const f32x4*)gfin + lane;
#pragma unroll
        for (int j = 0; j < 4; ++j) xr[64 * j] = xr[64 * j] * rs * gr[64 * j];
    }
}

struct Args { const float* in[18]; float* out; unsigned char* ws; int ph_lo, ph_hi; };
static_assert(sizeof(Args) == 168, "Args layout");

__global__ void __launch_bounds__(NTHREADS) mk_fwd(Args a) {
    extern __shared__ __attribute__((aligned(16))) unsigned char lds_raw[];
    LAS unsigned char* lds = (LAS unsigned char*)lds_raw;
    cg::grid_group grid = cg::this_grid();
    const int G = gridDim.x, bx = blockIdx.x;
    const int vcu = __builtin_amdgcn_readfirstlane((G % 8 == 0) ? (bx % 8) * (G / 8) + bx / 8 : bx);
    const __attribute__((address_space(4))) unsigned char* ka = (const __attribute__((address_space(4))) unsigned char*)__builtin_amdgcn_kernarg_segment_ptr();
    const int ph_lo = *(const __attribute__((address_space(4))) int*)(ka + 160), ph_hi = *(const __attribute__((address_space(4))) int*)(ka + 164);
    if (threadIdx.x < 16) ((LAS unsigned*)(lds + LDS_BAR_OFF))[threadIdx.x] = 0u;
    __syncthreads();
    XcdBarrier xbar = xcd_barrier_post((unsigned*)(*(unsigned char* const __attribute__((address_space(4)))*)(ka + 152) + WS_BAR), (volatile LAS unsigned*)(lds + LDS_BAR_OFF));
    unsigned long long tacc = 0ull;
    for (int ph = ph_lo; ph < ph_hi; ++ph) {
        unsigned long long tp0 = 0ull; int pclass = 0, lastk = -1; if (PROBE) tp0 = __builtin_amdgcn_s_memrealtime();
        const int tid = opaque_tid(), lane = tid & 63, wave = __builtin_amdgcn_readfirstlane(tid >> 6);
        const __attribute__((address_space(4))) unsigned char* kp = ka; asm volatile("" : "+s"(kp));
#define KARG_F(i) (*(const float* const __attribute__((address_space(4)))*)(kp + 8 * (i)))
        unsigned char* ws = *(unsigned char* const __attribute__((address_space(4)))*)(kp + 152);
        float* const outp = *(float* const __attribute__((address_space(4)))*)(kp + 144);
        float* tb = (float*)(ws + WS_TB); float* vsq = (float*)(ws + WS_VSQ); float* xsq = (float*)(ws + WS_XSQ);
        bf16* Win_t = (bf16*)(ws + WS_WIN); bf16* Wbr_t = (bf16*)(ws + WS_WBR); bf16* Wout_t = (bf16*)(ws + WS_WOUT); bf16* Wup_t = (bf16*)(ws + WS_WUP); bf16* Wdn_t = (bf16*)(ws + WS_WDN);
        bf16* xb = (bf16*)(ws + WS_XB); bf16* proj = (bf16*)(ws + WS_PROJ); bf16* upb = (bf16*)(ws + WS_PROJ); bf16* mrg = (bf16*)(ws + WS_MRG); bf16* hg = (bf16*)(ws + WS_MRG);
#define x_prompt KARG_F(0)
#define x_sample KARG_F(1)
#define rel_bias KARG_F(2)
#define g_mix KARG_F(3)
#define w_in KARG_F(4)
#define sgu_g KARG_F(5)
#define sgu_w KARG_F(6)
#define sgu_b KARG_F(7)
#define lam_qk KARG_F(8)
#define sub_g KARG_F(9)
#define w_br KARG_F(10)
#define w_out KARG_F(11)
#define g_ffn KARG_F(12)
#define w_up KARG_F(13)
#define conv_w KARG_F(14)
#define conv_b KARG_F(15)
#define w_down KARG_F(16)
#define g_final KARG_F(17)

        if (ph == 0) { if EN(7) {
            LAS float* scr = (LAS float*)(lds + wave * 16384);
            const int gw = vcu * NWAVES + wave, NGW = G * NWAVES;
            constexpr int I_IN = (DM / 64) * (INC / 32), I_SQ = (DM / 64) * (DM / 32), I_UP = (DM / 64) * (DFF2 / 32), I_DN = (DFF / 64) * (DM / 32);
            constexpr int I_L = I_IN + 3 * I_SQ + I_UP + I_DN;
            for (int it = gw; it < DEPTH * I_L; it += NGW) {
                const int l = it / I_L; int r = it - l * I_L;
                if (r < I_IN) { transpose_item(w_in + (size_t)l * DM * INC, g_mix + l * DM, DM, INC, Win_t + (size_t)l * INC * DM, scr, r, lane); continue; } r -= I_IN;
                if (r < 2 * I_SQ) { const int j = r / I_SQ; transpose_item(w_br + (size_t)(l * 2 + j) * DM * DM, nullptr, DM, DM, Wbr_t + (size_t)(l * 2 + j) * DM * DM, scr, r - j * I_SQ, lane); continue; } r -= 2 * I_SQ;
                if (r < I_SQ) { transpose_item(w_out + (size_t)l * DM * DM, nullptr, DM, DM, Wout_t + (size_t)l * DM * DM, scr, r, lane); continue; } r -= I_SQ;
                if (r < I_UP) { transpose_item(w_up + (size_t)l * DM * DFF2, g_ffn + l * DM, DM, DFF2, Wup_t + (size_t)l * DFF2 * DM, scr, r, lane, true); continue; } r -= I_UP;
                transpose_item(w_down + (size_t)l * DFF * DM, nullptr, DFF, DM, Wdn_t + (size_t)l * DM * DFF, scr, r, lane);
            }
            for (int i = bx * NTHREADS + tid; i < 8 * 4096; i += G * NTHREADS) { const int h = i >> 12, rel = (i & 4095) - 2048; tb[i] = rel_bias[rel_bucket(rel) * 8 + h] * LOG2E; }
            for (int m = gw; m < MT; m += NGW) {
                const float* src = (m < MG) ? x_prompt + (size_t)m * DM : x_sample + (size_t)(m - MG) * DM;
                const f32x4* xr = (const f32x4*)src + lane;
                f32x4 v[4]; float s = 0.f;
#pragma unroll
                for (int j = 0; j < 4; ++j) { v[j] = xr[64 * j]; s += (v[j][0] * v[j][0] + v[j][1] * v[j][1]) + (v[j][2] * v[j][2] + v[j][3] * v[j][3]); }
                s = wave_sum(s);
                u32x2* o8 = (u32x2*)(xb + (size_t)m * DM) + lane;
#pragma unroll
                for (int j = 0; j < 4; ++j) { u32x2 w; w.x = cvtpk(v[j][0], v[j][1]); w.y = cvtpk(v[j][2], v[j][3]); o8[64 * j] = w; }
                if (lane < 16) xsq[(size_t)m * 16 + lane] = (lane == 0) ? s : 0.f;
            }
        } } else {
            const int q = ph - 1; const bool last = (q == NGROUP * 12); const int g = last ? NGROUP - 1 : q / 12, k15 = last ? 14 : q % 12;
            const size_t grow0 = (size_t)g * MG;
            const float* xin_g = (g == 0) ? x_prompt : x_sample + (size_t)(g - 1) * MG * DM;
            float* xres = outp + grow0 * DM; bf16* xb_g = xb + grow0 * DM; float* xsq_g = xsq + grow0 * 16;
            if (k15 == 14) { if EN(8) { final_norm_group(xres, xsq_g, g_final, vcu * NWAVES + wave, G * NWAVES, lane);
            } } else {
                const int l = k15 / 6, k = k15 % 6;
                pclass = (k == 1) ? 1 : 2; lastk = k;
                if (k == 0) { if EN(0) {
                    if (l == 0 && g > 0) final_norm_group(outp + (grow0 - MG) * DM, xsq + (grow0 - MG) * 16, g_final, vcu * NWAVES + wave, G * NWAVES, lane);
                    pg8::Gemm gm{xb_g, Win_t + (size_t)l * INC * DM, DM, INC, DM, MG}; pg8::StaticOrder S; S.init(MG, INC, G, bx);
                    pg8::EpiRow<0> E{proj, INC, xsq_g, vsq, 0.125f * LOG2E};
                    pg8::gemm_phase<pg8::EpiRow<0>, pg8::StaticOrder, true, true>(lds, gm, S, E);
                } } else if (k == 1) { if EN(1) {
#ifndef NO_ATT
                    for (int i = 0; ; ++i) { int bh, qb; if (G == 256) { if (i >= 4) break; const int j = vcu & 31; bh = (vcu >> 5) * 8 + (j & 7); qb = 4 * i + (j >> 3); } else { const int id = i * G + vcu; if (id >= 1024) break; bh = id >> 4; qb = id & 15; }
                        att::attn_unit(lds, proj, bh >> 3, bh & 7, qb, tb + (bh & 7) * 4096, lam_qk + l * 256, l, sub_g + l * 128); __syncthreads(); }
#endif
                    if (PROBE == 5) tp0 = __builtin_amdgcn_s_memrealtime();
#ifndef NO_SGU
                    sgu::sgu_phase(lds, proj, vcu, G, sgu_w + (size_t)l * 8 * 128 * 128, sgu_b + l * 8 * 128, sgu_g + l * DM, vsq);
#endif
                    if (PROBE == 5) { pclass = 5; }
                } } else if (k == 2) { if EN(2) {
                    pg8::Gemm gm{proj + C_U, Wbr_t + (size_t)(l * 2) * DM * DM, INC, DM, DM, MG, (size_t)(C_Q - C_U) * 2, (size_t)DM * DM * 2}; pg8::PairOrder S; S.init(MG, DM, G, bx);
                    pg8::EpiGate3 E{mrg, proj + C_GA, INC};
                    pg8::gemm_phase<pg8::EpiGate3, pg8::PairOrder, true, true>(lds, gm, S, E);
                } } else if (k == 3) { if EN(3) {
                    pg8::Gemm gm{mrg, Wout_t + (size_t)l * DM * DM, DM, DM, DM, MG}; pg8::StaticOrder S; S.init(MG, DM, G, bx);
                    if (l == 0) { pg8::EpiResid<0, 1> E{xin_g, nullptr, xb_g, xsq_g}; pg8::gemm_phase<pg8::EpiResid<0, 1>, pg8::StaticOrder, true, true>(lds, gm, S, E); }
                    else { pg8::EpiResid<1, 1> E{nullptr, nullptr, xb_g, xsq_g}; pg8::gemm_phase<pg8::EpiResid<1, 1>, pg8::StaticOrder, true, true>(lds, gm, S, E); }
                } } else if (k == 4) { if EN(4) {
                    pg8::Gemm gm{xb_g, Wup_t + (size_t)l * DFF2 * DM, DM, DFF2, DM, MG}; pg8::StaticOrder S; S.init(MG, DFF2, G, bx);
                    pg8::EpiConv E{hg, (bf16*)(ws + WS_PROJ), xsq_g, conv_w + (size_t)l * 3 * DFF2, conv_b + (size_t)l * DFF2};
                    pg8::gemm_phase<pg8::EpiConv, pg8::StaticOrder, true, true>(lds, gm, S, E);
                } } else { if EN(6) {
                    { pg8::StaticOrder S0; S0.init(MG, DM, G, bx); pg8::Unit u0;
                      for (int i = 0; S0.next(i, u0); ++i) conv_edge_fixup((const bf16*)(ws + WS_PROJ), hg, conv_w + (size_t)l * 3 * DFF2, conv_b + (size_t)l * DFF2, u0.pm, tid);
                      asm volatile("s_waitcnt vmcnt(0)" ::: "memory"); __syncthreads(); }
                    pg8::Gemm gm{hg, Wdn_t + (size_t)l * DM * DFF, DFF, DM, DFF, MG}; pg8::StaticOrder S; S.init(MG, DM, G, bx);
                    if (l == 0) { pg8::EpiResid<1, 1> E{nullptr, nullptr, xb_g, xsq_g}; pg8::gemm_phase<pg8::EpiResid<1, 1>, pg8::StaticOrder, true, true>(lds, gm, S, E); }
                    else { pg8::EpiResid<1, 2> E{nullptr, xres, xb_g, xsq_g}; pg8::gemm_phase<pg8::EpiResid<1, 2>, pg8::StaticOrder, true, true>(lds, gm, S, E); }
                } }
            }
        }
        if (PROBE) { const unsigned long long tp1 = __builtin_amdgcn_s_memrealtime(); if (pclass == PROBE || (PROBE >= 10 && PROBE < 16 && lastk == PROBE - 10)) tacc += tp1 - tp0; tp0 = tp1; }
        if (ph + 1 < ph_hi) { if (ph == ph_lo) grid.sync(); else xcd_barrier(xbar); }
        if (PROBE == 4) tacc += __builtin_amdgcn_s_memrealtime() - tp0;
    }
    if (PROBE && bx == 0) { const unsigned long long te = __builtin_amdgcn_s_memrealtime() + tacc; while (__builtin_amdgcn_s_memrealtime() < te) __builtin_amdgcn_s_sleep(16); }
}

extern "C" void kernel_launch(void* const* d_in, const int* in_sizes, int n_in, void* d_out, int out_size, void* d_ws, size_t ws_size, hipStream_t stream) {
    static int grid = 0;
    if (grid == 0) {
        if (n_in != 18 || in_sizes[0] != MG * DM || in_sizes[1] != 2 * MG * DM || out_size != MT * DM || ws_size < WS_END) {
            fprintf(stderr, "kernel_launch: unexpected shapes (n_in %d, ws %zu); nothing launched\n", n_in, ws_size); grid = -1; return; }
        int dev = 0, cus = 0, per_cu = 0;
        hipGetDevice(&dev); hipDeviceGetAttribute(&cus, hipDeviceAttributeMultiprocessorCount, dev);
        if (hipFuncSetAttribute((const void*)mk_fwd, hipFuncAttributeMaxDynamicSharedMemorySize, LDS_BYTES) != hipSuccess) { fprintf(stderr, "kernel_launch: hipFuncSetAttribute failed\n"); grid = -1; return; }
        if (hipOccupancyMaxActiveBlocksPerMultiprocessor(&per_cu, (const void*)mk_fwd, NTHREADS, LDS_BYTES) != hipSuccess || per_cu < 1) { per_cu = 1; (void)hipGetLastError(); }
        grid = cus * 1;
        if (grid <= 0) { grid = -1; return; }
    }
    if (grid < 0) return;
    if (hipMemsetAsync((char*)d_ws + WS_BAR, 0, BAR_BYTES, stream) != hipSuccess) { fprintf(stderr, "kernel_launch: memset of the barrier words failed\n"); return; }
    Args a{};
    for (int i = 0; i < 18; ++i) a.in[i] = (const float*)d_in[i];
    a.out = (float*)d_out; a.ws = (unsigned char*)d_ws;
#if MK_SINGLE
    a.ph_lo = 0; a.ph_hi = NPH;
    void* args[] = {&a};
    hipError_t e = hipLaunchCooperativeKernel((const void*)mk_fwd, dim3(grid), dim3(NTHREADS), args, LDS_BYTES, stream);
    if (e != hipSuccess) fprintf(stderr, "cooperative launch failed: %s (grid %d)\n", hipGetErrorString(e), grid);
#else
    for (int ph = 0; ph < NPH; ++ph) { a.ph_lo = ph; a.ph_hi = ph + 1; hipLaunchKernelGGL(mk_fwd, dim3(grid), dim3(NTHREADS), LDS_BYTES, stream, a); }
#endif
}
```
